# Optimizing an MI355X kernel written in HIP

```python
import math
import jax, jax.numpy as jnp
from jax import lax
import numpy as np

D_MODEL = 1024
BATCH = 4
SEQ = 8192
DEPTH = 4

N_MIXERS = 2
N_CONV_LAYERS = (DEPTH + 1) // 2
N_ATTN_LAYERS = DEPTH // 2
WIDTH = D_MODEL
N_PROJ = 4
CONV_K = 3
N_DIFF_HEADS = 8
HEAD_DIM = 64
V_DIM = 2 * HEAD_DIM
N_MAPS = 2 * N_DIFF_HEADS
NUM_BUCKETS = 32
MAX_EXACT = NUM_BUCKETS // 2
REL_MAX_DIST = 128
Q_BLOCK = 128
RMS_EPS = 1e-6

kernel_name = "hybrid_shortconv_diffattn_trunk"


def rmsnorm(x, g):
    xf = x.astype(jnp.float32)
    y = xf * lax.rsqrt(jnp.mean(xf * xf, axis=-1, keepdims=True) + RMS_EPS)
    return (y * g.astype(jnp.float32)).astype(x.dtype)


def t5_causal_bucket(dist):
    d_safe = jnp.maximum(dist, 1).astype(jnp.float32)
    large = MAX_EXACT + (jnp.log(d_safe / MAX_EXACT) / math.log(REL_MAX_DIST / MAX_EXACT)
                         * (NUM_BUCKETS - MAX_EXACT)).astype(jnp.int32)
    large = jnp.minimum(large, NUM_BUCKETS - 1)
    return jnp.where(dist < MAX_EXACT, dist, large)


def lambda_init_for(layer_idx):
    return 0.8 - 0.6 * math.exp(-0.3 * layer_idx)


def short_conv_mixer(h, w_in, w_out, conv_w):
    s = h.shape[1]
    proj = h @ w_in
    b_gate, c_gate, u, z = jnp.split(proj, N_PROJ, axis=-1)
    v = c_gate * u
    vp = jnp.pad(v, ((0, 0), (CONV_K - 1, 0), (0, 0)))
    conv = (vp[:, 0:s] * conv_w[:, 0] + vp[:, 1:s + 1] * conv_w[:, 1]
            + vp[:, 2:s + 2] * conv_w[:, 2])
    y = b_gate * conv * jax.nn.silu(z)
    return y @ w_out


def diff_attn_mixer(h, w_in, w_out, lq1, lk1, lq2, lk2, subln_g, bias_dist, lambda_init):
    bsz, s = h.shape[0], h.shape[1]
    proj = h @ w_in
    q, k, v, z = jnp.split(proj, N_PROJ, axis=-1)
    q = q.reshape(bsz, s, N_MAPS, HEAD_DIM)
    k = k.reshape(bsz, s, N_MAPS, HEAD_DIM)
    v = v.reshape(bsz, s, N_DIFF_HEADS, V_DIM)
    lam = (jnp.exp(jnp.sum(lq1.astype(jnp.float32) * lk1.astype(jnp.float32)))
           - jnp.exp(jnp.sum(lq2.astype(jnp.float32) * lk2.astype(jnp.float32)))
           + lambda_init)
    scale = HEAD_DIM ** -0.5
    n_blk = s // Q_BLOCK
    q_blocks = q.reshape(bsz, n_blk, Q_BLOCK, N_MAPS, HEAD_DIM).transpose(1, 0, 2, 3, 4)
    k_pos = jnp.arange(s, dtype=jnp.int32)

    def block(args):
        q_blk, blk_idx = args
        q_pos = blk_idx * Q_BLOCK + jnp.arange(Q_BLOCK, dtype=jnp.int32)
        logits = jnp.einsum('bqhd,bkhd->bhqk', q_blk, k,
                            preferred_element_type=jnp.float32) * scale
        dist = q_pos[:, None] - k_pos[None, :]
        bias = bias_dist[:, jnp.maximum(dist, 0)].astype(jnp.float32)
        logits = jnp.where(dist[None, None] >= 0, logits + bias[None], -jnp.inf)
        p = jax.nn.softmax(logits, axis=-1).reshape(bsz, N_DIFF_HEADS, 2, Q_BLOCK, s)
        a = p[:, :, 0] - lam * p[:, :, 1]
        o = jnp.einsum('bhqk,bkhe->bqhe', a.astype(v.dtype), v)
        return rmsnorm(o, subln_g) * (1.0 - lambda_init)

    o = lax.map(block, (q_blocks, jnp.arange(n_blk, dtype=jnp.int32)))
    o = o.transpose(1, 0, 2, 3, 4).reshape(bsz, s, N_DIFF_HEADS * V_DIM)
    return (o * jax.nn.silu(z)) @ w_out


def setup_inputs(seed: int = 0) -> dict:
    key = jax.random.key(seed)
    ks = jax.random.split(key, 13)
    f32 = jnp.float32
    x = jax.random.normal(ks[0], (BATCH, SEQ, D_MODEL), f32)
    norm_g = 1.0 + 0.02 * jax.random.normal(ks[1], (DEPTH, D_MODEL), f32)
    w_in = jax.random.normal(ks[2], (DEPTH, D_MODEL, N_PROJ * WIDTH), f32) * D_MODEL ** -0.5
    w_out = jax.random.normal(ks[3], (DEPTH, WIDTH, D_MODEL), f32) * WIDTH ** -0.5
    conv_w = jax.random.normal(ks[4], (N_CONV_LAYERS, WIDTH, CONV_K), f32) * CONV_K ** -0.5
    lambda_q1 = 0.1 * jax.random.normal(ks[5], (N_ATTN_LAYERS, HEAD_DIM), f32)
    lambda_k1 = 0.1 * jax.random.normal(ks[6], (N_ATTN_LAYERS, HEAD_DIM), f32)
    lambda_q2 = 0.1 * jax.random.normal(ks[7], (N_ATTN_LAYERS, HEAD_DIM), f32)
    lambda_k2 = 0.1 * jax.random.normal(ks[8], (N_ATTN_LAYERS, HEAD_DIM), f32)
    subln_g = 1.0 + 0.02 * jax.random.normal(ks[9], (N_ATTN_LAYERS, V_DIM), f32)
    rel_bias = 0.5 * jax.random.normal(ks[10], (NUM_BUCKETS, N_MAPS), f32)
    final_g = 1.0 + 0.02 * jax.random.normal(ks[11], (D_MODEL,), f32)
    return {"x": x, "norm_g": norm_g, "w_in": w_in, "w_out": w_out, "conv_w": conv_w,
            "lambda_q1": lambda_q1, "lambda_k1": lambda_k1, "lambda_q2": lambda_q2,
            "lambda_k2": lambda_k2, "subln_g": subln_g, "rel_bias": rel_bias,
            "final_g": final_g}


def reference(x, norm_g, w_in, w_out, conv_w, lambda_q1, lambda_k1, lambda_q2, lambda_k2,
              subln_g, rel_bias, final_g):
    s = x.shape[1]
    bias_dist = rel_bias[t5_causal_bucket(jnp.arange(s, dtype=jnp.int32))].T
    for i in range(DEPTH):
        h = rmsnorm(x, norm_g[i])
        j = i // N_MIXERS
        if i % N_MIXERS == 0:
            out = short_conv_mixer(h, w_in[i], w_out[i], conv_w[j])
        else:
            out = diff_attn_mixer(h, w_in[i], w_out[i], lambda_q1[j], lambda_k1[j],
                                  lambda_q2[j], lambda_k2[j], subln_g[j], bias_dist,
                                  lambda_init_for(i))
        x = x + out
    return rmsnorm(x, final_g)
```

```cpp
#include <hip/hip_runtime.h>
#include <hip/hip_cooperative_groups.h>
#include <hip/hip_bf16.h>
#include <cstdio>
#include <cstdint>
#include <cmath>
namespace cg = cooperative_groups;
template <int K> __device__ __forceinline__ float swz_xor(float v) { return __int_as_float(__builtin_amdgcn_ds_swizzle(__float_as_int(v), (K << 10) | 0x1f)); }
__device__ __forceinline__ float half_sum32(float v) { v += swz_xor<1>(v); v += swz_xor<2>(v); v += swz_xor<4>(v); v += swz_xor<8>(v); v += swz_xor<16>(v); return v; }
__device__ __forceinline__ float wave_sum64(float v) { v = half_sum32(v); auto rr = __builtin_amdgcn_permlane32_swap(__float_as_uint(v), __float_as_uint(v), false, false); return __uint_as_float(rr[0]) + __uint_as_float(rr[1]); }
__device__ __forceinline__ int fresh_tid() { int t = threadIdx.x; asm volatile("" : "+v"(t)); return t; }
namespace pg8 {
#define PG8_LAS __attribute__((address_space(3)))
typedef unsigned short bf16_t;
typedef short bf16x8 __attribute__((ext_vector_type(8)));
typedef float f32x4 __attribute__((ext_vector_type(4)));
typedef unsigned u32x4 __attribute__((ext_vector_type(4)));
constexpr int BM = 256, BK = 64, HALF = 128, HTB = HALF * BK * 2  , STAGE_BYTES = 8 * HTB, NXCD = 8, WGM = 8;

__host__ __device__ __forceinline__ int lds_byte(int r, int c) { const int st = (r >> 4) * 2 + (c >> 5), rr = r & 15, cc = c & 31, ob = rr * 64 + cc * 2; return st * 1024 + (ob ^ (((ob >> 9) & 1) << 5)); }
__host__ __device__ __forceinline__ void stage_rc(int b, int& R, int& C) { const int st = b / 1024, sb = b % 1024, swz = sb ^ (((sb >> 9) & 1) << 5); R = (st >> 1) * 16 + swz / 64; C = (st & 1) * 32 + (swz % 64) / 2; }
__host__ __device__ __forceinline__ int perm32(int rho) { const int n = rho >> 4, i = rho & 15; return 8 * (i >> 2) + 4 * n + (i & 3); }

struct Unit { int pm, pn; };
struct Gemm { const bf16_t* A; const bf16_t* Bt; int M, N, K; };

struct StaticOrder {
    int nM, nN, nwg, G, c;
    __host__ __device__ void init(int M, int N, int G_, int c_) { nM = M / BM; nN = N / BM; nwg = nM * nN; G = G_; c = c_; }
    __host__ __device__ bool next(int i, Unit& u) const {
        const long L = (long)i * G + c; if (L >= nwg) return false;
        int wgid = (int)L; { const int q = nwg / NXCD, r = nwg % NXCD, xcd = wgid % NXCD, off = wgid / NXCD; wgid = (xcd < r ? xcd * (q + 1) : r * (q + 1) + (xcd - r) * q) + off; }
        const int nig = WGM * nN, gid = wgid / nig, fm = gid * WGM, gsz = (nM - fm) < WGM ? (nM - fm) : WGM;
        u.pm = fm + ((wgid % nig) % gsz); u.pn = (wgid % nig) / gsz; return true;
    }
    __device__ __forceinline__ void a_ready(const Unit&) const {}
    __device__ __forceinline__ void done(const Unit&) const {}
};


typedef float cvt_f32x2 __attribute__((ext_vector_type(2))); typedef __bf16 cvt_bf16x2 __attribute__((ext_vector_type(2)));
__device__ __forceinline__ unsigned cvt_pk_bf16(float lo, float hi) { cvt_f32x2 v = {lo, hi}; cvt_bf16x2 b = __builtin_convertvector(v, cvt_bf16x2); return __builtin_bit_cast(unsigned, b); }
__device__ __forceinline__ float silu_f(float z) { return z * __builtin_amdgcn_rcpf(1.0f + __builtin_amdgcn_exp2f(-1.4426950408889634f * z)); }

struct EpiBf16 {
    static constexpr bool PERM = true, AFTER_DRAIN = false;
    bf16_t* O; int ldc; int scale_cols; float scale0;
    __device__ __forceinline__ void operator()(const f32x4 (&acc)[2][2][4][2], const Unit& u, int wr, int wc, int fr, int fq) const {
        const int row0 = u.pm * BM + wr * 64 + fr; const int colt = u.pn * BM;
        const float sc = (colt < scale_cols) ? scale0 : 1.f;
        const int col0 = colt + wc * 32 + 8 * fq;
#pragma unroll
        for (int ai = 0; ai < 2; ++ai)
#pragma unroll
            for (int m = 0; m < 4; ++m) { bf16_t* rowp = O + (size_t)(row0 + ai * HALF + m * 16) * ldc + col0;
#pragma unroll
                for (int bj = 0; bj < 2; ++bj) { f32x4 v0 = acc[ai][bj][m][0] * sc, v1 = acc[ai][bj][m][1] * sc;
                    u32x4 w; w.x = cvt_pk_bf16(v0[0], v0[1]); w.y = cvt_pk_bf16(v0[2], v0[3]); w.z = cvt_pk_bf16(v1[0], v1[1]); w.w = cvt_pk_bf16(v1[2], v1[3]);
                    *(u32x4*)(rowp + bj * HALF) = w; } }
    }
};
struct EpiAttn {
    static constexpr bool PERM = true, AFTER_DRAIN = false;
    bf16_t* QZ; unsigned char* KV; float scale0;
    __device__ __forceinline__ void operator()(const f32x4 (&acc)[2][2][4][2], const Unit& u, int wr, int wc, int fr, int fq) const {
        const int part = u.pn >> 2;
        if (part == 0 || part == 3) {
            const float sc = (part == 0) ? scale0 : 1.f;
            const int row0 = u.pm * BM + wr * 64 + fr; const int col0 = (part == 0 ? 0 : 1024) + (u.pn & 3) * BM + wc * 32 + 8 * fq;
#pragma unroll
            for (int ai = 0; ai < 2; ++ai)
#pragma unroll
                for (int m = 0; m < 4; ++m) { bf16_t* rowp = QZ + (size_t)(row0 + ai * HALF + m * 16) * 2048 + col0;
#pragma unroll
                    for (int bj = 0; bj < 2; ++bj) { f32x4 v0 = acc[ai][bj][m][0] * sc, v1 = acc[ai][bj][m][1] * sc;
                        u32x4 w; w.x = cvt_pk_bf16(v0[0], v0[1]); w.y = cvt_pk_bf16(v0[2], v0[3]); w.z = cvt_pk_bf16(v1[0], v1[1]); w.w = cvt_pk_bf16(v1[2], v1[3]);
                        *(u32x4*)(rowp + bj * HALF) = w; } }
        } else if (part == 1) {
            const int b = u.pm >> 5, t0 = (u.pm & 31) * 4 + wr;
            const int inner = (4 * wc + fq) * 1024 + fr * 16;
#pragma unroll
            for (int bj = 0; bj < 2; ++bj) { const int h = (u.pn & 3) * 2 + bj;
#pragma unroll
                for (int ai = 0; ai < 2; ++ai) { unsigned char* img = KV + ((size_t)((b * 8 + h) * 128 + t0 + 2 * ai) << 15) + inner;
#pragma unroll
                    for (int m = 0; m < 4; ++m) { const f32x4 v0 = acc[ai][bj][m][0], v1 = acc[ai][bj][m][1];
                        u32x4 w; w.x = cvt_pk_bf16(v0[0], v0[1]); w.y = cvt_pk_bf16(v0[2], v0[3]); w.z = cvt_pk_bf16(v1[0], v1[1]); w.w = cvt_pk_bf16(v1[2], v1[3]);
                        *(u32x4*)(img + m * 256) = w; } } }
        } else {
            const int b = u.pm >> 5, t0 = (u.pm & 31) * 4 + wr;
            const int inner = 16384 + wc * 4096 + ((fr >> 2) & 1) * 512 + (8 * fq) * 16 + ((fr & 3) + 4 * (fr >> 3)) * 2;
#pragma unroll
            for (int bj = 0; bj < 2; ++bj) { const int h = (u.pn & 3) * 2 + bj;
#pragma unroll
                for (int ai = 0; ai < 2; ++ai) { unsigned char* img = KV + ((size_t)((b * 8 + h) * 128 + t0 + 2 * ai) << 15) + inner;
#pragma unroll
                    for (int m = 0; m < 4; ++m) { const f32x4 v0 = acc[ai][bj][m][0], v1 = acc[ai][bj][m][1];
                        const unsigned w0 = cvt_pk_bf16(v0[0], v0[1]), w1 = cvt_pk_bf16(v0[2], v0[3]), w2 = cvt_pk_bf16(v1[0], v1[1]), w3 = cvt_pk_bf16(v1[2], v1[3]);
                        unsigned short* p = (unsigned short*)(img + m * 1024);
                        p[0 * 8] = (unsigned short)w0; p[1 * 8] = (unsigned short)(w0 >> 16); p[2 * 8] = (unsigned short)w1; p[3 * 8] = (unsigned short)(w1 >> 16);
                        p[4 * 8] = (unsigned short)w2; p[5 * 8] = (unsigned short)(w2 >> 16); p[6 * 8] = (unsigned short)w3; p[7 * 8] = (unsigned short)(w3 >> 16); } } }
        }
    }
};
struct EpiConvGate {
    static constexpr bool PERM = true, AFTER_DRAIN = false;
    bf16_t* Vb; bf16_t* Gb;
    __device__ __forceinline__ void operator()(const f32x4 (&acc)[2][2][4][2], const Unit& u, int wr, int wc, int fr, int fq) const {
        const int row0 = u.pm * BM + wr * 64 + fr;
        const bool isg = wc >= 2;
        bf16_t* base = (isg ? Gb : Vb) + u.pn * 64 + (wc & 1) * 32 + 8 * fq;
#pragma unroll
        for (int ai = 0; ai < 2; ++ai)
#pragma unroll
            for (int m = 0; m < 4; ++m) { bf16_t* rowp = base + (size_t)(row0 + ai * HALF + m * 16) * 1024;
                f32x4 a0 = acc[ai][0][m][0], a1 = acc[ai][0][m][1], b0 = acc[ai][1][m][0], b1 = acc[ai][1][m][1];
                if (isg) {
#pragma unroll
                    for (int e = 0; e < 4; ++e) { b0[e] = silu_f(b0[e]); b1[e] = silu_f(b1[e]); }
                }
                const f32x4 v0 = a0 * b0, v1 = a1 * b1;
                u32x4 w; w.x = cvt_pk_bf16(v0[0], v0[1]); w.y = cvt_pk_bf16(v0[2], v0[3]); w.z = cvt_pk_bf16(v1[0], v1[1]); w.w = cvt_pk_bf16(v1[2], v1[3]);
                *(u32x4*)rowp = w; }
    }
};
struct EpiRes {
    static constexpr bool PERM = false, AFTER_DRAIN = false;
    const float* base; float* out; int ldc;
    __device__ __forceinline__ void operator()(const f32x4 (&acc)[2][2][4][2], const Unit& u, int wr, int wc, int fr, int fq) const {
        const int col0 = u.pn * BM + wc * 32 + 4 * fq;
#pragma unroll
        for (int ai = 0; ai < 2; ++ai) {
            const size_t off0 = (size_t)(u.pm * BM + ai * HALF + wr * 64 + fr) * ldc + col0;
            f32x4 pre[4][2][2];
#pragma unroll
            for (int m = 0; m < 4; ++m)
#pragma unroll
                for (int bj = 0; bj < 2; ++bj)
#pragma unroll
                    for (int n = 0; n < 2; ++n) pre[m][bj][n] = __builtin_nontemporal_load((const f32x4*)(base + off0 + (size_t)(m * 16) * ldc + bj * HALF + n * 16));
#pragma unroll
            for (int m = 0; m < 4; ++m)
#pragma unroll
                for (int bj = 0; bj < 2; ++bj)
#pragma unroll
                    for (int n = 0; n < 2; ++n) *(f32x4*)(out + off0 + (size_t)(m * 16) * ldc + bj * HALF + n * 16) = pre[m][bj][n] + acc[ai][bj][m][n];
            asm volatile("" ::: "memory");
        }
    }
};

template <class Epi, class Sched, bool ALIGN_EPI = false, bool SP2 = false>
__device__ __forceinline__ void gemm_phase(PG8_LAS unsigned char* lds, const Gemm g, const Sched& S, const Epi& E) {
    const int tid = fresh_tid(), wid = __builtin_amdgcn_readfirstlane(tid >> 6), lane = tid & 63, wr = wid >> 2, wc = wid & 3, fr = lane & 15, fq = lane >> 4;
    const int K = g.K, nt = K / BK;
    unsigned voffA[2], voffB[2];
#pragma unroll
    for (int i = 0; i < 2; ++i) { int R, C; stage_rc(tid * 16 + i * 8192, R, C); const int Rb = Epi::PERM ? ((R & ~31) + perm32(R & 31)) : R;
        voffA[i] = (unsigned)(R * K + C) * 2u; voffB[i] = (unsigned)(Rb * K + C) * 2u; }
    const size_t kstep = (size_t)(BK * 2);
    const size_t hstep = (size_t)HALF * K * 2;
    const size_t tstep = 2 * hstep;
    const unsigned ldsw = (unsigned)wid * 1024u;
    const int aoff = lds_byte(wr * 64 + fr, fq * 8), boff = lds_byte(wc * 32 + fr, fq * 8);
#define PG8_SA(b, h) (((b) * 2 + (h)) * HTB)
#define PG8_SB(b, h) ((4 + (b) * 2 + (h)) * HTB)
#define PG8_STAGE(bufoff, gbase, voff) do { _Pragma("unroll") for (int _i = 0; _i < 2; ++_i) \
        __builtin_amdgcn_global_load_lds((const unsigned*)((const char*)(gbase) + (voff)[_i]), (PG8_LAS unsigned*)(lds + (bufoff) + ldsw + _i * 8192), 16, 0, 0); } while (0)
#define PG8_LDA(dst, b, h) do { _Pragma("unroll") for (int m = 0; m < 4; ++m) _Pragma("unroll") for (int k = 0; k < 2; ++k) dst[m][k] = *(const PG8_LAS bf16x8*)(lds + PG8_SA(b, h) + aoff + m * 2048 + k * 1024); } while (0)
#define PG8_LDB(dst, b, h) do { _Pragma("unroll") for (int n = 0; n < 2; ++n) _Pragma("unroll") for (int k = 0; k < 2; ++k) dst[n][k] = *(const PG8_LAS bf16x8*)(lds + PG8_SB(b, h) + boff + n * 2048 + k * 1024); } while (0)
#define PG8_MMA(ai, bj, At, Bt) do { __builtin_amdgcn_s_setprio(1); _Pragma("unroll") for (int m = 0; m < 4; ++m) _Pragma("unroll") for (int n = 0; n < 2; ++n) _Pragma("unroll") for (int k = 0; k < 2; ++k) \
        acc[ai][bj][m][n] = __builtin_amdgcn_mfma_f32_16x16x32_bf16(Bt[n][k], At[m][k], acc[ai][bj][m][n], 0, 0, 0); __builtin_amdgcn_s_setprio(0); } while (0)
#define PG8_WAIT_V(n) asm volatile("s_waitcnt vmcnt(" #n ")" ::: "memory")
#define PG8_WAIT_L(n) asm volatile("s_waitcnt lgkmcnt(" #n ")" ::: "memory")
#define PG8_BAR __builtin_amdgcn_s_barrier()
#define PG8_SCHED __builtin_amdgcn_sched_barrier(0)
    Unit cur, nxt; int ui = 0;
    if (!S.next(0, cur)) return;
    f32x4 acc[2][2][4][2];
#pragma unroll
    for (int a = 0; a < 2; ++a)
#pragma unroll
        for (int b = 0; b < 2; ++b)
#pragma unroll
            for (int m = 0; m < 4; ++m)
#pragma unroll
                for (int n = 0; n < 2; ++n) acc[a][b][m][n] = (f32x4){0.f, 0.f, 0.f, 0.f};
    bf16x8 At[4][2], B0[2][2], B1[2][2];
    const char* cA = (const char*)g.A + (size_t)cur.pm * tstep; const char* cB = (const char*)g.Bt + (size_t)cur.pn * tstep;
    S.a_ready(cur);
    if constexpr (SP2) {
        PG8_STAGE(PG8_SB(0, 0), cB, voffB); PG8_STAGE(PG8_SB(0, 1), cB + hstep, voffB); PG8_STAGE(PG8_SA(0, 0), cA, voffA); PG8_STAGE(PG8_SA(0, 1), cA + hstep, voffA);
        if (wr == 1) PG8_BAR;
        PG8_WAIT_V(2); PG8_BAR;
        PG8_STAGE(PG8_SB(1, 0), cB + kstep, voffB); PG8_STAGE(PG8_SA(1, 0), cA + kstep, voffA); PG8_STAGE(PG8_SB(1, 1), cB + hstep + kstep, voffB);
        PG8_WAIT_V(6); PG8_BAR;
    } else {
        PG8_STAGE(PG8_SB(0, 0), cB, voffB); PG8_STAGE(PG8_SA(0, 0), cA, voffA); PG8_STAGE(PG8_SB(0, 1), cB + hstep, voffB); PG8_STAGE(PG8_SA(0, 1), cA + hstep, voffA);
        if (wr == 1) PG8_BAR;
        PG8_WAIT_V(4); PG8_BAR;
        PG8_STAGE(PG8_SB(1, 0), cB + kstep, voffB); PG8_STAGE(PG8_SA(1, 0), cA + kstep, voffA); PG8_STAGE(PG8_SB(1, 1), cB + hstep + kstep, voffB);
        PG8_WAIT_V(6); PG8_BAR;
    }
    for (;;) {
        const bool has_next = S.next(ui + 1, nxt);
        const char* nA = has_next ? (const char*)g.A + (size_t)nxt.pm * tstep : cA; const char* nB = has_next ? (const char*)g.Bt + (size_t)nxt.pn * tstep : cB;
        for (int t = 0; t < nt; t += 2) {
            const bool last = (t == nt - 2);
            const char* a1 = cA + (size_t)(t + 1) * kstep;
            const char* a2 = last ? nA : cA + (size_t)(t + 2) * kstep; const char* b2 = last ? nB : cB + (size_t)(t + 2) * kstep;
            const char* a3 = a2 + kstep; const char* b3 = b2 + kstep;
            if (last && has_next) S.a_ready(nxt);
            if constexpr (SP2) {
            PG8_LDB(B0, 0, 0); PG8_LDB(B1, 0, 1); PG8_SCHED; PG8_LDA(At, 0, 0); PG8_STAGE(PG8_SA(1, 1), a1 + hstep, voffA);
            PG8_WAIT_V(8); PG8_WAIT_L(0); PG8_BAR; PG8_MMA(0, 0, At, B0); PG8_MMA(0, 1, At, B1); PG8_BAR; PG8_SCHED;
            PG8_LDA(At, 0, 1); PG8_STAGE(PG8_SB(0, 0), b2, voffB); PG8_STAGE(PG8_SB(0, 1), b2 + hstep, voffB); PG8_STAGE(PG8_SA(0, 0), a2, voffA);
            PG8_WAIT_V(8); PG8_WAIT_L(0); PG8_BAR; PG8_MMA(1, 0, At, B0); PG8_MMA(1, 1, At, B1); PG8_BAR; PG8_SCHED;
            PG8_LDB(B0, 1, 0); PG8_LDB(B1, 1, 1); PG8_SCHED; PG8_LDA(At, 1, 0); PG8_STAGE(PG8_SA(0, 1), a2 + hstep, voffA);
            PG8_WAIT_V(8); PG8_WAIT_L(0); PG8_BAR; PG8_MMA(0, 0, At, B0); PG8_MMA(0, 1, At, B1); PG8_BAR; PG8_SCHED;
            PG8_LDA(At, 1, 1); PG8_STAGE(PG8_SB(1, 0), b3, voffB); PG8_STAGE(PG8_SB(1, 1), b3 + hstep, voffB); PG8_STAGE(PG8_SA(1, 0), a3, voffA);
            PG8_WAIT_V(8); PG8_WAIT_L(0); PG8_BAR; PG8_MMA(1, 0, At, B0); PG8_MMA(1, 1, At, B1); PG8_BAR; PG8_SCHED;
            } else {
            PG8_LDB(B0, 0, 0); PG8_SCHED; PG8_LDA(At, 0, 0); PG8_STAGE(PG8_SA(1, 1), a1 + hstep, voffA);
            PG8_WAIT_L(8); PG8_BAR; PG8_WAIT_L(0); PG8_MMA(0, 0, At, B0); PG8_BAR; PG8_SCHED;
            PG8_LDB(B1, 0, 1); PG8_STAGE(PG8_SB(0, 0), b2, voffB);
            PG8_BAR; PG8_WAIT_L(0); PG8_MMA(0, 1, At, B1); PG8_BAR;
            PG8_LDA(At, 0, 1); PG8_STAGE(PG8_SA(0, 0), a2, voffA);
            PG8_BAR; PG8_WAIT_L(0); PG8_MMA(1, 0, At, B0); PG8_BAR; PG8_SCHED;
            PG8_STAGE(PG8_SB(0, 1), b2 + hstep, voffB);
            PG8_WAIT_V(6); PG8_BAR; PG8_MMA(1, 1, At, B1); PG8_BAR;
            PG8_LDB(B0, 1, 0); PG8_SCHED; PG8_LDA(At, 1, 0); PG8_STAGE(PG8_SA(0, 1), a2 + hstep, voffA);
            PG8_WAIT_L(8); PG8_BAR; PG8_WAIT_L(0); PG8_MMA(0, 0, At, B0); PG8_BAR; PG8_SCHED;
            PG8_LDB(B1, 1, 1); PG8_STAGE(PG8_SB(1, 0), b3, voffB);
            PG8_BAR; PG8_WAIT_L(0); PG8_MMA(0, 1, At, B1); PG8_BAR;
            PG8_LDA(At, 1, 1); PG8_STAGE(PG8_SA(1, 0), a3, voffA);
            PG8_BAR; PG8_WAIT_L(0); PG8_MMA(1, 0, At, B0); PG8_BAR; PG8_SCHED;
            PG8_STAGE(PG8_SB(1, 1), b3 + hstep, voffB);
            PG8_WAIT_V(6); PG8_BAR; PG8_MMA(1, 1, At, B1); PG8_BAR;
            }
        }
        if constexpr (ALIGN_EPI) { if (wr == 0) PG8_BAR; }
        if constexpr (!Epi::AFTER_DRAIN) { E(acc, cur, wr, wc, fr, fq); S.done(cur); }
        if (!has_next) break;
#pragma unroll
        for (int a = 0; a < 2; ++a)
#pragma unroll
            for (int b = 0; b < 2; ++b)
#pragma unroll
                for (int m = 0; m < 4; ++m)
#pragma unroll
                    for (int n = 0; n < 2; ++n) acc[a][b][m][n] = (f32x4){0.f, 0.f, 0.f, 0.f};
        cur = nxt; cA = nA; cB = nB; ++ui;
        if constexpr (ALIGN_EPI) { if (wr == 1) PG8_BAR; }
    }
    PG8_WAIT_V(0);
    if constexpr (!ALIGN_EPI) { if (wr == 0) PG8_BAR; }
    PG8_BAR;
    if constexpr (Epi::AFTER_DRAIN) { E.fused(acc, cur, wr, wc, fr, fq, lds, wid, lane); S.done(cur); }
#undef PG8_SA
#undef PG8_SB
#undef PG8_STAGE
#undef PG8_LDA
#undef PG8_LDB
#undef PG8_MMA
#undef PG8_WAIT_V
#undef PG8_WAIT_L
#undef PG8_BAR
#undef PG8_SCHED
}
}

namespace attn_body {
using bf16x8=__attribute__((ext_vector_type(8)))short;
using s16x4=__attribute__((ext_vector_type(4)))short;
using f32x16=__attribute__((ext_vector_type(16)))float;
using u32x4=__attribute__((ext_vector_type(4)))unsigned;
using f32x4g=__attribute__((ext_vector_type(4)))float;
typedef unsigned short bf16raw;
constexpr int SEQ=8192,PITCH=2048,YP=1024,NHEAD=8;
constexpr int NW=8,QBLK=32,QB=128,KVBLK=64,NQB=SEQ/QB;
constexpr int SLOT16=16384;
constexpr int LDS_KR=0,LDS_VR=3*SLOT16;
constexpr int LDS_WS=6*SLOT16, LDS_BIAS=LDS_WS+NW*64*4, LDS_DUMMY=LDS_BIAS+2048, LDS_BYTES=LDS_DUMMY+16384;
constexpr float LOG2E=1.4426950408889634f;
constexpr float C2=0.125f*LOG2E;
__device__ __forceinline__ int crow(int r,int hi){return (r&3)+8*(r>>2)+4*hi;}
#define SBAR() __builtin_amdgcn_sched_barrier(0)
__device__ __forceinline__ void glds16(const void*gsrc,unsigned lds_dst){unsigned keep;
  asm volatile("s_mov_b32 %0, m0\n\ts_mov_b32 m0, %2\n\ts_nop 0\n\tglobal_load_lds_dwordx4 %1, off\n\ts_mov_b32 m0, %0":"=&s"(keep):"v"(gsrc),"s"(lds_dst):"memory");}
__device__ __forceinline__ void glds16s(const void*sbase,unsigned voff,unsigned lds_dst){unsigned keep;
  asm volatile("s_mov_b32 %0, m0\n\ts_mov_b32 m0, %3\n\ts_nop 0\n\tglobal_load_lds_dwordx4 %2, %1\n\ts_mov_b32 m0, %0":"=&s"(keep):"s"(sbase),"v"(voff),"s"(lds_dst):"memory");}
typedef float f32x2_t __attribute__((ext_vector_type(2))); typedef __bf16 bf16x2_t __attribute__((ext_vector_type(2)));
__device__ __forceinline__ unsigned cvtpk_s(float lo,float hi){f32x2_t v={lo,hi};bf16x2_t b=__builtin_convertvector(v,bf16x2_t);return __builtin_bit_cast(unsigned,b);}
__device__ __forceinline__ float bf2f(bf16raw v){return __uint_as_float(((unsigned)v)<<16);}
#define WAIT_BAR(N) asm volatile("s_waitcnt vmcnt(" #N ") lgkmcnt(0)\n\ts_barrier":::"memory")
typedef __attribute__((address_space(3))) const char* lds_cptr;
typedef short v4i16_t __attribute__((ext_vector_type(4)));
__device__ __forceinline__ s16x4 vtr(lds_cptr p){ return __builtin_bit_cast(s16x4,__builtin_amdgcn_ds_read_tr16_b64_v4i16((__attribute__((address_space(3))) v4i16_t*)p)); }
__device__ __forceinline__ int t5_bucket(int d){ if(d<16)return d; int b=16+(int)(__builtin_log2f((float)d*(1.0f/16.0f))*(16.0f/3.0f)); return b>31?31:b; }

__device__ __forceinline__ void qkt(f32x16&p0,f32x16&p1,lds_cptr kb,const bf16x8*qr){
  const f32x16 z=f32x16{};
  #pragma unroll
  for(int d0=0;d0<4;++d0){
    const bf16x8 b0=*(const __attribute__((address_space(3))) bf16x8*)(kb+d0*2048);
    const bf16x8 b1=*(const __attribute__((address_space(3))) bf16x8*)(kb+d0*2048+512);
    if(d0==0){p0=__builtin_amdgcn_mfma_f32_32x32x16_bf16(b0,qr[0],z,0,0,0);p1=__builtin_amdgcn_mfma_f32_32x32x16_bf16(b1,qr[0],z,0,0,0);}
    else{p0=__builtin_amdgcn_mfma_f32_32x32x16_bf16(b0,qr[d0],p0,0,0,0);p1=__builtin_amdgcn_mfma_f32_32x32x16_bf16(b1,qr[d0],p1,0,0,0);}}
}
__device__ __forceinline__ float rowmax(const f32x16&p0,const f32x16&p1){
  float a=p0[0];
  #pragma unroll
  for(int r=1;r<16;++r)a=__builtin_fmaxf(a,p0[r]);
  float c=p1[0];
  #pragma unroll
  for(int r=1;r<16;++r)c=__builtin_fmaxf(c,p1[r]);
  a=__builtin_fmaxf(a,c);
  auto rr=__builtin_amdgcn_permlane32_swap(__float_as_uint(a),__float_as_uint(a),false,false);
  return __builtin_fmaxf(__uint_as_float(rr[0]),__uint_as_float(rr[1]));
}

struct AttnArgs { const bf16raw* P; const unsigned char* KV; bf16raw* Y; const float* relb; const float* subg; float lam; float onem; };

template<int THRL> __device__ __forceinline__ void attn_unit(int b,int h,int qb,const AttnArgs&A,char*shm,bool setup){
  const int tid=fresh_tid(),lane=tid&63,r32=lane&31,hi=lane>>5; const int wid=__builtin_amdgcn_readfirstlane(tid>>6);
  const int rg=wid&3,mp=wid>>2;
  const long rowbase=(long)b*SEQ; const int q0=qb*QB; const int qw0=q0+rg*QBLK;
  const bf16raw*Qw=A.P+(rowbase+qw0)*PITCH+(2*h+mp)*64;
  const unsigned char*imgS=A.KV+((size_t)((b*NHEAD+h)*(SEQ/KVBLK))<<15);
  const unsigned voff=(unsigned)(wid*1024+lane*16);
  const unsigned lds0=(unsigned)(uintptr_t)shm;
  float*wsf=(float*)(shm+LDS_WS)+wid*64;
  float*biasT=(float*)(shm+LDS_BIAS);
  float*xch=(float*)shm+rg*4096+lane;
  const lds_cptr shm3=(lds_cptr)shm;
  float*subgT=biasT+256;
  if(setup){
    if(tid<256){ const int m_=tid>>7,d=tid&127; biasT[tid]=A.relb[t5_bucket(d)*16+2*h+m_]*LOG2E; }
    else if(tid<384){ subgT[tid-256]=A.subg[tid-256]*A.onem; }
    asm volatile("s_waitcnt vmcnt(0) lgkmcnt(0)\n\ts_barrier":::"memory");
  }
  const float cfar=biasT[mp*128+127];
  const unsigned kdst=lds0+LDS_KR+wid*1024, vdst=lds0+LDS_VR+wid*1024, ddst=lds0+LDS_DUMMY+wid*1024;
  #define DMA_K(t,slot) do{ const unsigned char*g_=imgS+((size_t)(t)<<15); \
      glds16s(g_,voff,(unsigned)__builtin_amdgcn_readfirstlane(kdst+(slot))); glds16s(g_+8192,voff,(unsigned)__builtin_amdgcn_readfirstlane(kdst+(slot)+8192)); }while(0)
  #define DMA_V(t,slot) do{ const unsigned char*g_=imgS+((size_t)(t)<<15)+16384; \
      glds16s(g_,voff,(unsigned)__builtin_amdgcn_readfirstlane(vdst+(slot))); glds16s(g_+8192,voff,(unsigned)__builtin_amdgcn_readfirstlane(vdst+(slot)+8192)); }while(0)
  const lds_cptr kp0=shm3+LDS_KR+mp*8192+hi*1024+r32*16;
  const lds_cptr vp0=shm3+LDS_VR+hi*512+r32*16;
  const int NT=(q0+QB)/KVBLK;
  bf16x8 qr[4];
  #pragma unroll
  for(int d0=0;d0<4;++d0)qr[d0]=*reinterpret_cast<const bf16x8*>(&Qw[(long)r32*PITCH+d0*16+hi*8]);
  DMA_K(0,0); DMA_V(0,0); DMA_K(1,SLOT16);
  DMA_V(1,SLOT16); { const unsigned char*g_=imgS+((size_t)(NT>2?2:NT-1)<<15); const unsigned d_=(unsigned)__builtin_amdgcn_readfirstlane(NT>2?kdst+2*SLOT16:ddst); glds16s(g_,voff,d_); glds16s(g_+8192,voff,d_+8192); }
  float mhat=0.f,l=0.f;
  f32x16 o[4];
  #pragma unroll
  for(int d0=0;d0<4;++d0)o[d0]=f32x16{};
  const int qpos=qw0+r32;
  f32x16 p0,p1; u32x4 pw[4]; bf16x8 kf[8]; bf16x8 va[4],vb[4];
  f32x16 cini;
  #pragma unroll
  for(int r=0;r<16;++r)cini[r]=cfar;
  asm volatile("":"+v"(cini));
  #define LDK(kp_,o_) (*(const __attribute__((address_space(3))) bf16x8*)((kp_)+(o_)))
  #define KRD(kp_) do{ _Pragma("unroll") for(int d0_=0;d0_<4;++d0_){ kf[2*d0_]=LDK(kp_,d0_*2048); kf[2*d0_+1]=LDK(kp_,d0_*2048+512); } }while(0)
  #define QKM(z_) do{ \
      p0=__builtin_amdgcn_mfma_f32_32x32x16_bf16(kf[0],qr[0],z_,0,0,0); \
      _Pragma("unroll") for(int d0_=1;d0_<4;++d0_){ p0=__builtin_amdgcn_mfma_f32_32x32x16_bf16(kf[2*d0_],qr[d0_],p0,0,0,0); } \
      p1=__builtin_amdgcn_mfma_f32_32x32x16_bf16(kf[1],qr[0],z_,0,0,0); \
      _Pragma("unroll") for(int d0_=1;d0_<4;++d0_){ p1=__builtin_amdgcn_mfma_f32_32x32x16_bf16(kf[2*d0_+1],qr[d0_],p1,0,0,0); } }while(0)
  #define VRK(dst,vp_,ks_) do{ _Pragma("unroll") for(int d0_=0;d0_<4;++d0_){ dst[d0_]=*(const __attribute__((address_space(3))) bf16x8*)((vp_)+d0_*4096+(ks_)*1024); } }while(0)
  #define VFR(src,ks_) (bf16x8){src[2*(ks_)][0],src[2*(ks_)][1],src[2*(ks_)][2],src[2*(ks_)][3],src[2*(ks_)+1][0],src[2*(ks_)+1][1],src[2*(ks_)+1][2],src[2*(ks_)+1][3]}
  #define PVM(d0_,src) do{ _Pragma("unroll") for(int ks_=0;ks_<4;++ks_) o[d0_]=__builtin_amdgcn_mfma_f32_32x32x16_bf16(__builtin_bit_cast(bf16x8,pw[ks_]),VFR(src,ks_),o[d0_],0,0,0); }while(0)
  WAIT_BAR(8);
  KRD(kp0);
  int ks_t=0,ks_n=SLOT16,vs_t=0,vs_nn=2*SLOT16;
  for(int t=0;t<NT;++t){
    WAIT_BAR(4);
    const int kv0=t*KVBLK;
    const bool act=(kv0<=qw0+QBLK-1);
    const bool actn=(t+1<NT)&&(kv0+KVBLK<=qw0+QBLK-1);
    const lds_cptr vp=vp0+vs_t;
    const bool dk=(t+3<NT), dv=(t+2<NT);
    const unsigned char*gk_=imgS+((size_t)(dk?t+3:NT-1)<<15); const unsigned char*gv_=imgS+((size_t)(dv?t+2:NT-1)<<15)+16384;
    const unsigned kd_=(unsigned)__builtin_amdgcn_readfirstlane(dk?kdst+ks_t:ddst), vd_=(unsigned)__builtin_amdgcn_readfirstlane(dv?vdst+vs_nn:ddst);
    if(act){
      VRK(va,vp,0); VRK(vb,vp,1);
      SBAR();
      if(qw0-(kv0+63)>=113){ QKM(cini); } else { const f32x16 z0_=f32x16{}; QKM(z0_); }
    }
    if(act){
      const bool far=(qw0-(kv0+63)>=113);
      if(!far){ const float*bt=biasT+mp*128; const int dq=qpos-kv0-4*hi;
        #pragma unroll
        for(int r=0;r<16;++r){ const int d=dq-((r&3)+8*(r>>2));
          const int i0=d<0?0:(d>127?127:d);
          const float b0=bt[i0];
          const float n0=d>=0?0.f:-INFINITY;
          p0[r]=(p0[r]+(b0-mhat))+n0; if((r&7)==7)asm volatile("":::"memory"); }
        #pragma unroll
        for(int r=0;r<16;++r){ const int d1=dq-32-((r&3)+8*(r>>2));
          const int i1=d1<0?0:(d1>127?127:d1);
          const float b1=bt[i1];
          const float n1=d1>=0?0.f:-INFINITY;
          p1[r]=(p1[r]+(b1-mhat))+n1; if((r&7)==7)asm volatile("":::"memory"); } }
      const float rm=rowmax(p0,p1);
      if(t==0||__any(rm>(float)THRL)){
        const float dl=(t==0)?rm:__builtin_fmaxf(rm,0.f);
        #pragma unroll
        for(int r=0;r<16;++r){p0[r]-=dl;p1[r]-=dl;}
        if(t>0){ const float f=__builtin_amdgcn_exp2f(-dl);
          l*=f;
          #pragma unroll
          for(int d0=0;d0<4;++d0)
            #pragma unroll
            for(int r=0;r<16;++r)o[d0][r]*=f; }
        mhat+=dl;
        { const float ci=cfar-mhat;
          #pragma unroll
          for(int r=0;r<16;++r)cini[r]=ci;
          asm volatile("":"+v"(cini)); }
      }
      #define EX2(P,B) do{ P[B]=__builtin_amdgcn_exp2f(P[B]); P[B+1]=__builtin_amdgcn_exp2f(P[B+1]); sacc+=P[B]; sacc+=P[B+1]; }while(0)
      #define QTR(P,B,W,I) do{ EX2(P,B); asm volatile("":"+v"(sacc)); { unsigned w_=cvtpk_s(P[B],P[B+1]); asm volatile("":"+v"(w_)); W[I]=w_; } }while(0)
      #define PV1(d0_,ks_,src) o[d0_]=__builtin_amdgcn_mfma_f32_32x32x16_bf16(src[d0_],__builtin_bit_cast(bf16x8,pw[ks_]),o[d0_],0,0,0)
      float sacc=0.f;
      QTR(p0,0,pw[0],0); QTR(p0,2,pw[0],1); QTR(p0,4,pw[0],2); QTR(p0,6,pw[0],3);
      SBAR();
      PV1(0,0,va); QTR(p0,8,pw[1],0);  SBAR();
      PV1(1,0,va); QTR(p0,10,pw[1],1); SBAR();
      PV1(2,0,va); QTR(p0,12,pw[1],2); SBAR();
      PV1(3,0,va); QTR(p0,14,pw[1],3); SBAR();
      VRK(va,vp,2); SBAR();
      PV1(0,1,vb); QTR(p1,0,pw[2],0);  SBAR();
      PV1(1,1,vb); QTR(p1,2,pw[2],1);  SBAR();
      PV1(2,1,vb); QTR(p1,4,pw[2],2);  SBAR();
      PV1(3,1,vb); QTR(p1,6,pw[2],3);  SBAR();
      VRK(vb,vp,3); SBAR();
      PV1(0,2,va); QTR(p1,8,pw[3],0);  SBAR();
      PV1(1,2,va); QTR(p1,10,pw[3],1); SBAR();
      PV1(2,2,va); QTR(p1,12,pw[3],2); SBAR();
      PV1(3,2,va); QTR(p1,14,pw[3],3); SBAR();
      if(actn){ KRD(kp0+ks_n); SBAR(); }
      PV1(0,3,vb); PV1(1,3,vb); PV1(2,3,vb); PV1(3,3,vb);
      l+=sacc;
      SBAR();
      #undef EX2
      #undef QTR
      #undef PV1
    }
    glds16s(gk_,voff,kd_); glds16s(gk_+8192,voff,kd_+8192); glds16s(gv_,voff,vd_); glds16s(gv_+8192,voff,vd_+8192);
    ks_t=ks_n; ks_n=(ks_n==2*SLOT16)?0:ks_n+SLOT16; vs_t=(vs_t==2*SLOT16)?0:vs_t+SLOT16; vs_nn=(vs_nn==2*SLOT16)?0:vs_nn+SLOT16;
  }
  #undef LDK
  #undef KRD
  #undef QKM
  #undef VRD
  #undef VRK
  #undef VFR
  #undef PVM
  {auto rr=__builtin_amdgcn_permlane32_swap(__float_as_uint(l),__float_as_uint(l),false,false);l=__uint_as_float(rr[0])+__uint_as_float(rr[1]);}
  const float ascl=(mp?A.lam:1.0f)/l;
  typedef unsigned u32x2e __attribute__((ext_vector_type(2)));
  u32x2e zq[4][4];
  const long orow=rowbase+qw0+r32;
  if(mp==0){
    const bf16raw*zp=A.P+orow*PITCH+1024+h*128+4*hi;
    #pragma unroll
    for(int d0=0;d0<4;++d0)
      #pragma unroll
      for(int g=0;g<4;++g)zq[d0][g]=*(const u32x2e*)(zp+d0*32+8*g);
  }
  asm volatile("s_waitcnt lgkmcnt(0)\n\ts_barrier":::"memory");
  if(mp==1){
    #pragma unroll
    for(int r=0;r<16;++r)
      #pragma unroll
      for(int d0=0;d0<4;++d0)xch[(d0*16+r)*64]=o[d0][r]*ascl;
  }
  asm volatile("s_waitcnt lgkmcnt(0)\n\ts_barrier":::"memory");
  if(mp==0){
    float ss=0.f;
    #pragma unroll
    for(int r=0;r<16;++r)
      #pragma unroll
      for(int d0=0;d0<4;++d0){ const float v_=o[d0][r]*ascl-xch[(d0*16+r)*64]; o[d0][r]=v_; ss+=v_*v_; }
    {auto rr=__builtin_amdgcn_permlane32_swap(__float_as_uint(ss),__float_as_uint(ss),false,false);ss=__uint_as_float(rr[0])+__uint_as_float(rr[1]);}
    const float rstd=__builtin_amdgcn_rsqf(ss*(1.0f/128.0f)+1e-6f);
    bf16raw*yp=A.Y+orow*YP+h*128+4*hi;
    #pragma unroll
    for(int d0=0;d0<4;++d0)
      #pragma unroll
      for(int g=0;g<4;++g){
        const f32x4g gs=*(const f32x4g*)(subgT+d0*32+8*g+4*hi);
        float y[4];
        #pragma unroll
        for(int e=0;e<4;++e){ const unsigned zw=(e<2)?zq[d0][g][0]:zq[d0][g][1]; const float z=__uint_as_float((e&1)?(zw&0xffff0000u):(zw<<16));
          const float sg=z*__builtin_amdgcn_rcpf(1.0f+__builtin_amdgcn_exp2f(-LOG2E*z)); y[e]=o[d0][4*g+e]*rstd*gs[e]*sg; }
        u32x2e w; w[0]=cvtpk_s(y[0],y[1]); w[1]=cvtpk_s(y[2],y[3]);
        *(u32x2e*)(yp+d0*32+8*g)=w; }
  }
  WAIT_BAR(0);
  #undef DMA_K
  #undef DMA_V
}
#undef WAIT_BAR
#undef SBAR
}

constexpr int NWAVES = 8;
constexpr int PROBE_ATTN_REP = 1;
constexpr int BATCH = 4, T = 8192, D = 1024, DEPTH = 4, NP = 4 * D;
constexpr int M = BATCH * T;
constexpr float RMS_EPS = 1e-6f;
constexpr size_t MiB = 1u << 20;
constexpr size_t WS_WIN = 2 * MiB;
constexpr size_t WS_WOUT = 34 * MiB;
constexpr size_t WS_XN = 48 * MiB;
constexpr size_t WS_Y = 112 * MiB;
constexpr size_t WS_P = 176 * MiB;
constexpr size_t WS_END = 432 * MiB;
constexpr int RING_BYTES = 131072;
constexpr int LDS_BYTES = 147456;
static_assert(attn_body::LDS_BYTES <= RING_BYTES, "attention LDS");

#define GAS __attribute__((address_space(1)))
#define LAS __attribute__((address_space(3)))
typedef unsigned short bf16;
typedef unsigned v4u __attribute__((ext_vector_type(4)));
typedef float f32x4 __attribute__((ext_vector_type(4)));
#define LDS_WAIT() asm volatile("s_waitcnt lgkmcnt(0)" ::: "memory")
__device__ __forceinline__ unsigned f2bf(float f) { unsigned u = __builtin_bit_cast(unsigned, f); return (u + 0x7fffu + ((u >> 16) & 1u)) >> 16; }
__device__ __forceinline__ unsigned pk2(float lo, float hi) { return f2bf(lo) | (f2bf(hi) << 16); }
__device__ __forceinline__ float wave_sum(float v) { return wave_sum64(v); }
__device__ __forceinline__ void p0_transpose_item(const float* W, int K, int N, bf16* WT, int conv, LAS float* scrf, int item, int lane, const float* gk) {
    LAS unsigned short* scr = (LAS unsigned short*)scrf;
    constexpr int TP = 68;
    const int nblk = N / 64, kb = item / nblk, nb = item % nblk, k0 = 64 * kb, n0 = 64 * nb;
    const int lr = lane >> 4, lc = (lane & 15) * 4;
    f32x4 v[16];
#pragma unroll
    for (int i = 0; i < 16; ++i) v[i] = __builtin_nontemporal_load((const f32x4*)(W + (size_t)(k0 + 4 * i + lr) * N + n0 + lc));
#pragma unroll
    for (int i = 0; i < 16; ++i) { const float g_ = gk ? gk[k0 + 4 * i + lr] : 1.0f; const f32x4 y = v[i] * g_;
        *(LAS unsigned long long*)(scr + (4 * i + lr) * TP + lc) = (unsigned long long)pk2(y.x, y.y) | ((unsigned long long)pk2(y.z, y.w) << 32); }
    LDS_WAIT(); asm volatile("" ::: "memory");
    int dn0 = n0;
    if (conv) { const int part = n0 >> 10, ch = n0 & 1023, pn = ch >> 6; const int slot = (part == 0) ? 1 : (part == 1) ? 0 : part; dn0 = 256 * pn + 64 * slot; }
    const int c = lane & 7;
#pragma unroll
    for (int j = 0; j < 8; ++j) { const int n = (lane >> 3) + 8 * j; const LAS unsigned short* s_ = scr + (8 * c) * TP + n;
        v4u o; o.x = (unsigned)s_[0 * TP] | ((unsigned)s_[1 * TP] << 16); o.y = (unsigned)s_[2 * TP] | ((unsigned)s_[3 * TP] << 16);
        o.z = (unsigned)s_[4 * TP] | ((unsigned)s_[5 * TP] << 16); o.w = (unsigned)s_[6 * TP] | ((unsigned)s_[7 * TP] << 16);
        *(GAS v4u*)(WT + (size_t)(dn0 + n) * K + k0 + 8 * c) = o; }
    LDS_WAIT(); asm volatile("" ::: "memory");
}
__device__ __forceinline__ void rms_rows_bf16(const float* X, const float* g, bf16* XN, int gw, int NGW, int) {
    constexpr int NR = 4;
    const int lane = fresh_tid() & 63;
    f32x4 gv[4];
#pragma unroll
    for (int j = 0; j < 4; ++j) gv[j] = ((const f32x4*)g)[64 * j + lane];
    for (int m = gw; m < M; m += NR * NGW) {
        f32x4 v[NR][4]; float s[NR];
#pragma unroll
        for (int k = 0; k < NR; ++k) { const int mk = (m + k * NGW < M) ? m + k * NGW : m; const GAS f32x4* xr = (const GAS f32x4*)(X + (size_t)mk * D) + lane;
#pragma unroll
            for (int j = 0; j < 4; ++j) v[k][j] = __builtin_nontemporal_load((const f32x4*)(xr + 64 * j)); }
#pragma unroll
        for (int k = 0; k < NR; ++k) { float a = 0.f;
#pragma unroll
            for (int j = 0; j < 4; ++j) a += (v[k][j].x * v[k][j].x + v[k][j].y * v[k][j].y) + (v[k][j].z * v[k][j].z + v[k][j].w * v[k][j].w);
            s[k] = __builtin_amdgcn_rsqf(wave_sum(a) * (1.f / D) + RMS_EPS); }
#pragma unroll
        for (int k = 0; k < NR; ++k) if (m + k * NGW < M) { GAS unsigned long long* o8 = (GAS unsigned long long*)(XN + (size_t)(m + k * NGW) * D) + lane;
#pragma unroll
            for (int j = 0; j < 4; ++j) { const f32x4 y = v[k][j] * s[k] * gv[j]; o8[64 * j] = (unsigned long long)pk2(y.x, y.y) | ((unsigned long long)pk2(y.z, y.w) << 32); } }
    }
}
__device__ __forceinline__ void rms_rows_f32_inplace(float* X, const float* g, int gw, int NGW, int) {
    constexpr int NR = 4;
    const int lane = fresh_tid() & 63;
    f32x4 gv[4];
#pragma unroll
    for (int j = 0; j < 4; ++j) gv[j] = ((const f32x4*)g)[64 * j + lane];
    for (int m = gw; m < M; m += NR * NGW) {
        f32x4 v[NR][4]; float s[NR];
#pragma unroll
        for (int k = 0; k < NR; ++k) { const int mk = (m + k * NGW < M) ? m + k * NGW : m; const GAS f32x4* xr = (const GAS f32x4*)(X + (size_t)mk * D) + lane;
#pragma unroll
            for (int j = 0; j < 4; ++j) v[k][j] = __builtin_nontemporal_load((const f32x4*)(xr + 64 * j)); }
#pragma unroll
        for (int k = 0; k < NR; ++k) { float a = 0.f;
#pragma unroll
            for (int j = 0; j < 4; ++j) a += (v[k][j].x * v[k][j].x + v[k][j].y * v[k][j].y) + (v[k][j].z * v[k][j].z + v[k][j].w * v[k][j].w);
            s[k] = __builtin_amdgcn_rsqf(wave_sum(a) * (1.f / D) + RMS_EPS); }
#pragma unroll
        for (int k = 0; k < NR; ++k) if (m + k * NGW < M) { GAS f32x4* xr = (GAS f32x4*)(X + (size_t)(m + k * NGW) * D) + lane;
#pragma unroll
            for (int j = 0; j < 4; ++j) xr[64 * j] = v[k][j] * s[k] * gv[j]; }
    }
}
__device__ __forceinline__ float bfl(unsigned w) { return __uint_as_float(w << 16); }
__device__ __forceinline__ float bfh(unsigned w) { return __uint_as_float(w & 0xffff0000u); }
__device__ __forceinline__ void conv_pass(const bf16* Vb, const bf16* Gb, const float* cw  , bf16* Y, int gtid, int nthreads) {
    const int chunk = gtid & 127; const int r0 = gtid >> 7, rstep = nthreads >> 7;
    float w0[8], w1[8], w2[8];
#pragma unroll
    for (int e = 0; e < 8; ++e) { const float* p = cw + (size_t)(chunk * 8 + e) * 3; w0[e] = p[0]; w1[e] = p[1]; w2[e] = p[2]; }
    constexpr int NRC = 4;
    for (int row = r0; row < M; row += NRC * rstep) {
        v4u c2[NRC], c1[NRC], c0[NRC], gg[NRC]; size_t off[NRC];
#pragma unroll
        for (int k = 0; k < NRC; ++k) { const int rw = row + k * rstep; const int rr = rw < M ? rw : row; const int s = rr & (T - 1);
            off[k] = (size_t)rr * D + chunk * 8;
            c2[k] = *(const GAS v4u*)(Vb + off[k]); c1[k] = (v4u){0u, 0u, 0u, 0u}; c0[k] = (v4u){0u, 0u, 0u, 0u};
            if (s >= 1) c1[k] = *(const GAS v4u*)(Vb + off[k] - D);
            if (s >= 2) c0[k] = *(const GAS v4u*)(Vb + off[k] - 2 * D);
            gg[k] = *(const GAS v4u*)(Gb + off[k]); }
#pragma unroll
        for (int k = 0; k < NRC; ++k) { if (row + k * rstep < M) { v4u o;
#pragma unroll
            for (int q = 0; q < 4; ++q) {
                const float ylo = bfl(gg[k][q]) * (w0[2 * q] * bfl(c0[k][q]) + w1[2 * q] * bfl(c1[k][q]) + w2[2 * q] * bfl(c2[k][q]));
                const float yhi = bfh(gg[k][q]) * (w0[2 * q + 1] * bfh(c0[k][q]) + w1[2 * q + 1] * bfh(c1[k][q]) + w2[2 * q + 1] * bfh(c2[k][q]));
                o[q] = pk2(ylo, yhi);
            }
            *(GAS v4u*)(Y + off[k]) = o; } }
    }
}

typedef GAS unsigned gu32;
#define XB_TMO      128
#define XB_XCNT(j)  (256  + 64 * (j))
#define XB_XSUB(j)  (1280 + 64 * (j))
#define XB_XGEN(j)  (2304 + 64 * (j))
#define XB_TOP      3328
#define XB_TOPGEN   3392
#define XCD_BAR_WORDS 3456
#define XB_SPIN_CAP (1u << 18)

__device__ __forceinline__ unsigned xb_ld(unsigned* p)              { return __hip_atomic_load(p, __ATOMIC_RELAXED, __HIP_MEMORY_SCOPE_AGENT); }
__device__ __forceinline__ unsigned xb_add(unsigned* p, unsigned v) { return __hip_atomic_fetch_add(p, v, __ATOMIC_RELAXED, __HIP_MEMORY_SCOPE_AGENT); }
__device__ __forceinline__ unsigned xb_xcc_id() { return (unsigned)__builtin_amdgcn_s_getreg((3 << 11) | 20) & 0xFu; }
#define XB_SPIN(cond, bar) do { unsigned _sp = 0; while (cond) { __builtin_amdgcn_s_sleep(1); \
    if ((++_sp & 255u) == 0u) { if (xb_ld(&(bar)[XB_TMO])) break; if (_sp > XB_SPIN_CAP) { atomicAdd(&(bar)[XB_TMO], 1u); break; } } } } while (0)

struct XcdBarrier {
    unsigned* bar; unsigned x;
    volatile LAS unsigned* st;
};

__device__ __forceinline__ XcdBarrier xcd_barrier_post(unsigned* bar, volatile LAS unsigned* st) {
    XcdBarrier b; b.bar = bar; b.x = xb_xcc_id(); b.st = st;
    if (threadIdx.x == 0) (void)xb_add(&bar[XB_XCNT(b.x)], 1u);
    return b;
}
__device__ __forceinline__ void xcd_barrier_complete(unsigned* bar, unsigned x, unsigned& nloc, unsigned& nx) {
    const unsigned G = gridDim.x * gridDim.y * gridDim.z;
    unsigned sum, cnt, mine, sp = 0u;
    for (;;) {
        sum = 0u; cnt = 0u; mine = 0u;
#pragma unroll
        for (unsigned j = 0; j < 16; ++j) { const unsigned c = xb_ld(&bar[XB_XCNT(j)]); sum += c; cnt += (c > 0u) ? 1u : 0u; mine = (j == x) ? c : mine; }
        if (sum == G) break;
        __builtin_amdgcn_s_sleep(1);
        if ((++sp & 255u) == 0u) { if (xb_ld(&bar[XB_TMO])) break; if (sp > XB_SPIN_CAP) { atomicAdd(&bar[XB_TMO], 1u); break; } }
    }
    nloc = mine > 0u ? mine : 1u; nx = cnt > 0u ? cnt : 1u;
}

__device__ __forceinline__ void xcd_barrier(const XcdBarrier& b) {
    asm volatile("s_waitcnt vmcnt(0)" ::: "memory");
    __syncthreads();
    if (threadIdx.x == 0) {
        unsigned* bar = b.bar;
        __builtin_amdgcn_s_waitcnt(0);
        unsigned nloc = b.st[0], nx = b.st[1];
        if (nloc == 0u) { xcd_barrier_complete(bar, b.x, nloc, nx); b.st[0] = nloc; b.st[1] = nx; }
        const unsigned old = xb_add(&bar[XB_XSUB(b.x)], 1u);
        const unsigned gen = old / nloc;
        if (old + 1u == (gen + 1u) * nloc) {
            __builtin_amdgcn_fence(__ATOMIC_RELEASE, "agent");
            asm volatile("s_waitcnt vmcnt(0)" ::: "memory");
            const unsigned og = xb_add(&bar[XB_TOP], 1u);
            const unsigned tg = og / nx;
            if (og + 1u == (tg + 1u) * nx) xb_add(&bar[XB_TOPGEN], 1u);
            else XB_SPIN(xb_ld(&bar[XB_TOPGEN]) == tg, bar);
            __builtin_amdgcn_fence(__ATOMIC_ACQUIRE, "agent");
            xb_add(&bar[XB_XGEN(b.x)], 1u);
            asm volatile("s_waitcnt vmcnt(0)" ::: "memory");
        } else {
            XB_SPIN(xb_ld(&bar[XB_XGEN(b.x)]) == gen, bar);
            __builtin_amdgcn_fence(__ATOMIC_ACQUIRE, "agent");
            asm volatile("s_waitcnt vmcnt(0)" ::: "memory");
        }
    }
    __syncthreads();
}

struct Args { const float* in[12]; float* out; unsigned char* ws; };
__global__ void __launch_bounds__(NWAVES * 64, 2) trunk_fwd(Args args) {
    extern __shared__ __attribute__((aligned(16))) unsigned char lds[];
    cg::grid_group grid = cg::this_grid();
    const int tid = threadIdx.x, lane = tid & 63, wave = __builtin_amdgcn_readfirstlane(tid >> 6);
    const int G = gridDim.x, bx = blockIdx.x;
    const int vcu = (G % 8 == 0) ? (bx % 8) * (G / 8) + bx / 8 : bx;
    const int gw = vcu * NWAVES + wave, NGW = G * NWAVES;
    unsigned char* ws = args.ws;
    const float* x_in = args.in[0]; const float* norm_g = args.in[1]; const float* w_in = args.in[2]; const float* w_out = args.in[3]; const float* conv_w = args.in[4];
    const float* lq1 = args.in[5]; const float* lk1 = args.in[6]; const float* lq2 = args.in[7]; const float* lk2 = args.in[8];
    const float* subln_g = args.in[9]; const float* rel_bias = args.in[10]; const float* final_g = args.in[11];
    float* X = args.out;
    bf16* Win_t = (bf16*)(ws + WS_WIN); bf16* Wout_t = (bf16*)(ws + WS_WOUT); bf16* XN = (bf16*)(ws + WS_XN); bf16* Y = (bf16*)(ws + WS_Y); bf16* P = (bf16*)(ws + WS_P);
    LAS unsigned char* ldsl = (LAS unsigned char*)lds;
    volatile LAS unsigned* MISC = (volatile LAS unsigned*)(ldsl + RING_BYTES + 320);
    if (tid < 32) MISC[tid] = 0u;
    __syncthreads();
    const XcdBarrier bar = xcd_barrier_post((unsigned*)ws, MISC + 8);
#define GRID_BAR() xcd_barrier(bar)

    {
        LAS float* scr = (LAS float*)(ldsl + wave * 16384);
        constexpr int I_IN = (D / 64) * (NP / 64), I_OUT = (D / 64) * (D / 64);
        constexpr int NITEMS = DEPTH * (I_IN + I_OUT);
        for (int it = gw; it < NITEMS; it += NGW) {
            if (it < DEPTH * I_IN) { const int l = it / I_IN, r = it % I_IN; p0_transpose_item(w_in + (size_t)l * D * NP, D, NP, Win_t + (size_t)l * NP * D, (l & 1) == 0, scr, r, lane, nullptr); }
            else { const int it2 = it - DEPTH * I_IN; const int l = it2 / I_OUT, r = it2 % I_OUT; p0_transpose_item(w_out + (size_t)l * D * D, D, D, Wout_t + (size_t)l * D * D, 0, scr, r, lane, nullptr); }
        }
        rms_rows_bf16(x_in, norm_g, XN, gw, NGW, lane);
    }
    grid.sync();

    for (int l = 0; l < DEPTH; ++l) {
        const bool is_attn = (l & 1) != 0; const int j = l >> 1;
        if (l > 0) { rms_rows_bf16(X, norm_g + (size_t)l * D, XN, gw, NGW, lane); GRID_BAR(); }
        {
            pg8::Gemm g{XN, Win_t + (size_t)l * NP * D, M, NP, D}; pg8::StaticOrder S; S.init(M, NP, G, bx);
            if (is_attn) { pg8::EpiAttn E{P, (unsigned char*)P + 128 * MiB, attn_body::C2}; pg8::gemm_phase<pg8::EpiAttn, pg8::StaticOrder, true, true>(ldsl, g, S, E); }
            else { pg8::EpiConvGate E{P, P + (size_t)M * D}; pg8::gemm_phase<pg8::EpiConvGate, pg8::StaticOrder, true, true>(ldsl, g, S, E); }
        }
        GRID_BAR();
        if (is_attn) {
            const float linit = 0.8f - 0.6f * expf(-0.3f * (float)l);
            const float d1 = wave_sum(lq1[j * 64 + lane] * lk1[j * 64 + lane]), d2 = wave_sum(lq2[j * 64 + lane] * lk2[j * 64 + lane]);
            const float lam = expf(d1) - expf(d2) + linit;
            for (int rep = 0; rep < PROBE_ATTN_REP; ++rep) {
            attn_body::AttnArgs A{P, (const unsigned char*)P + 128 * MiB, rep == 0 ? Y : XN, rel_bias, subln_g + (size_t)j * 128, lam, 1.0f - linit};
            for (int v = vcu; v < 256; v += G) {
                const int s = v & 7, bh = v >> 3;
#pragma unroll 1
                for (int i = 0; i < 8; ++i) { const int qb = (i & 1) ? (16 * (i >> 1) + 15 - s) : (16 * (i >> 1) + s);
                    attn_body::attn_unit<8>(bh / attn_body::NHEAD, bh % attn_body::NHEAD, qb, A, (char*)lds, i == 0); }
            }
            }
        } else {
            conv_pass(P, P + (size_t)M * D, conv_w + (size_t)j * D * 3, Y, vcu * (NWAVES * 64) + fresh_tid(), G * NWAVES * 64);
        }
        GRID_BAR();
        {
            pg8::Gemm g{Y, Wout_t + (size_t)l * D * D, M, D, D}; pg8::StaticOrder S; S.init(M, D, G, bx);
            pg8::EpiRes E{l == 0 ? x_in : X, X, D};
            pg8::gemm_phase<pg8::EpiRes, pg8::StaticOrder, true, true>(ldsl, g, S, E);
        }
        GRID_BAR();
    }
    rms_rows_f32_inplace(X, final_g, gw, NGW, lane);
}

extern "C" void kernel_launch(void* const* d_in, const int* in_sizes, int n_in, void* d_out, int out_size, void* d_ws, size_t ws_size, hipStream_t stream) {
    static int grid = 0;
    if (grid == 0) {
        if (n_in != 12 || in_sizes[0] != M * D || out_size != M * D || ws_size < WS_END) { fprintf(stderr, "kernel_launch: unexpected shapes: n_in %d in0 %d out %d ws %zu (need %zu)\n", n_in, n_in > 0 ? in_sizes[0] : -1, out_size, ws_size, (size_t)WS_END); grid = -1; return; }
        int dev = 0, cus = 0, per_cu = 0;
        hipGetDevice(&dev); hipDeviceGetAttribute(&cus, hipDeviceAttributeMultiprocessorCount, dev);
        if (hipFuncSetAttribute((const void*)trunk_fwd, hipFuncAttributeMaxDynamicSharedMemorySize, LDS_BYTES) != hipSuccess) { fprintf(stderr, "kernel_launch: hipFuncSetAttribute failed\n"); grid = -1; return; }
        if (hipOccupancyMaxActiveBlocksPerMultiprocessor(&per_cu, (const void*)trunk_fwd, NWAVES * 64, LDS_BYTES) != hipSuccess || per_cu < 1) { fprintf(stderr, "kernel_launch: occupancy query gave %d\n", per_cu); per_cu = 1; }
        (void)hipGetLastError();
        grid = cus;
        fprintf(stderr, "kernel_launch: grid %d (cus %d, per_cu %d)\n", grid, cus, per_cu);
    }
    if (grid < 0) return;
    if (hipMemsetAsync(d_ws, 0, 65536, stream) != hipSuccess) { fprintf(stderr, "kernel_launch: memset failed\n"); return; }
    Args a{};
    for (int i = 0; i < 12; ++i) a.in[i] = (const float*)d_in[i];
    a.out = (float*)d_out; a.ws = (unsigned char*)d_ws;
    void* kargs[] = {&a};
    hipError_t e = hipLaunchCooperativeKernel((const void*)trunk_fwd, dim3(grid), dim3(NWAVES * 64), kargs, LDS_BYTES, stream);
    if (e != hipSuccess) fprintf(stderr, "kernel_launch: cooperative launch failed: %s (grid %d)\n", hipGetErrorString(e), grid);
}
```

```cpp
#include <hip/hip_runtime.h>
#include <hip/hip_cooperative_groups.h>
#include <hip/hip_bf16.h>
#include <cstdio>
#include <cstdint>
#include <cmath>
namespace cg = cooperative_groups;
template <int K> __device__ __forceinline__ float swz_xor(float v) { return __int_as_float(__builtin_amdgcn_ds_swizzle(__float_as_int(v), (K << 10) | 0x1f)); }
__device__ __forceinline__ float half_sum32(float v) { v += swz_xor<1>(v); v += swz_xor<2>(v); v += swz_xor<4>(v); v += swz_xor<8>(v); v += swz_xor<16>(v); return v; }
__device__ __forceinline__ float wave_sum64(float v) { v = half_sum32(v); auto rr = __builtin_amdgcn_permlane32_swap(__float_as_uint(v), __float_as_uint(v), false, false); return __uint_as_float(rr[0]) + __uint_as_float(rr[1]); }
__device__ __forceinline__ int fresh_tid() { int t = threadIdx.x; asm volatile("" : "+v"(t)); return t; }
namespace pg8 {
#define PG8_LAS __attribute__((address_space(3)))
typedef unsigned short bf16_t;
typedef short bf16x8 __attribute__((ext_vector_type(8)));
typedef float f32x4 __attribute__((ext_vector_type(4)));
typedef unsigned u32x4 __attribute__((ext_vector_type(4)));
constexpr int BM = 256, BK = 64, HALF = 128, HTB = HALF * BK * 2  , STAGE_BYTES = 8 * HTB, NXCD = 8, WGM = 8;

__host__ __device__ __forceinline__ int lds_byte(int r, int c) { const int st = (r >> 4) * 2 + (c >> 5), rr = r & 15, cc = c & 31, ob = rr * 64 + cc * 2; return st * 1024 + (ob ^ (((ob >> 9) & 1) << 5)); }
__host__ __device__ __forceinline__ void stage_rc(int b, int& R, int& C) { const int st = b / 1024, sb = b % 1024, swz = sb ^ (((sb >> 9) & 1) << 5); R = (st >> 1) * 16 + swz / 64; C = (st & 1) * 32 + (swz % 64) / 2; }
__host__ __device__ __forceinline__ int perm32(int rho) { const int n = rho >> 4, i = rho & 15; return 8 * (i >> 2) + 4 * n + (i & 3); }

struct Unit { int pm, pn; };
struct Gemm { const bf16_t* A; const bf16_t* Bt; int M, N, K; };

struct StaticOrder {
    int nM, nN, nwg, G, c;
    __host__ __device__ void init(int M, int N, int G_, int c_) { nM = M / BM; nN = N / BM; nwg = nM * nN; G = G_; c = c_; }
    __host__ __device__ bool next(int i, Unit& u) const {
        const long L = (long)i * G + c; if (L >= nwg) return false;
        int wgid = (int)L; { const int q = nwg / NXCD, r = nwg % NXCD, xcd = wgid % NXCD, off = wgid / NXCD; wgid = (xcd < r ? xcd * (q + 1) : r * (q + 1) + (xcd - r) * q) + off; }
        const int nig = WGM * nN, gid = wgid / nig, fm = gid * WGM, gsz = (nM - fm) < WGM ? (nM - fm) : WGM;
        u.pm = fm + ((wgid % nig) % gsz); u.pn = (wgid % nig) / gsz; return true;
    }
    __device__ __forceinline__ void a_ready(const Unit&) const {}
    __device__ __forceinline__ void done(const Unit&) const {}
};


__device__ __forceinline__ unsigned cvt_pk_bf16(float lo, float hi) { unsigned r; asm volatile("v_cvt_pk_bf16_f32 %0, %1, %2" : "=v"(r) : "v"(lo), "v"(hi)); return r; }
__device__ __forceinline__ float silu_f(float z) { return z * __builtin_amdgcn_rcpf(1.0f + __builtin_amdgcn_exp2f(-1.4426950408889634f * z)); }

struct EpiBf16 {
    static constexpr bool PERM = true, AFTER_DRAIN = false;
    bf16_t* O; int ldc; int scale_cols; float scale0;
    __device__ __forceinline__ void operator()(const f32x4 (&acc)[2][2][4][2], const Unit& u, int wr, int wc, int fr, int fq) const {
        const int row0 = u.pm * BM + wr * 64 + fr; const int colt = u.pn * BM;
        const float sc = (colt < scale_cols) ? scale0 : 1.f;
        const int col0 = colt + wc * 32 + 8 * fq;
#pragma unroll
        for (int ai = 0; ai < 2; ++ai)
#pragma unroll
            for (int m = 0; m < 4; ++m) { bf16_t* rowp = O + (size_t)(row0 + ai * HALF + m * 16) * ldc + col0;
#pragma unroll
                for (int bj = 0; bj < 2; ++bj) { f32x4 v0 = acc[ai][bj][m][0] * sc, v1 = acc[ai][bj][m][1] * sc;
                    u32x4 w; w.x = cvt_pk_bf16(v0[0], v0[1]); w.y = cvt_pk_bf16(v0[2], v0[3]); w.z = cvt_pk_bf16(v1[0], v1[1]); w.w = cvt_pk_bf16(v1[2], v1[3]);
                    *(u32x4*)(rowp + bj * HALF) = w; } }
    }
};
struct EpiAttn {
    static constexpr bool PERM = true, AFTER_DRAIN = false;
    bf16_t* QZ; unsigned char* KV; float scale0;
    __device__ __forceinline__ void operator()(const f32x4 (&acc)[2][2][4][2], const Unit& u, int wr, int wc, int fr, int fq) const {
        const int part = u.pn >> 2;
        if (part == 0 || part == 3) {
            const float sc = (part == 0) ? scale0 : 1.f;
            const int row0 = u.pm * BM + wr * 64 + fr; const int col0 = (part == 0 ? 0 : 1024) + (u.pn & 3) * BM + wc * 32 + 8 * fq;
#pragma unroll
            for (int ai = 0; ai < 2; ++ai)
#pragma unroll
                for (int m = 0; m < 4; ++m) { bf16_t* rowp = QZ + (size_t)(row0 + ai * HALF + m * 16) * 2048 + col0;
#pragma unroll
                    for (int bj = 0; bj < 2; ++bj) { f32x4 v0 = acc[ai][bj][m][0] * sc, v1 = acc[ai][bj][m][1] * sc;
                        u32x4 w; w.x = cvt_pk_bf16(v0[0], v0[1]); w.y = cvt_pk_bf16(v0[2], v0[3]); w.z = cvt_pk_bf16(v1[0], v1[1]); w.w = cvt_pk_bf16(v1[2], v1[3]);
                        *(u32x4*)(rowp + bj * HALF) = w; } }
        } else if (part == 1) {
            const int b = u.pm >> 5, t0 = (u.pm & 31) * 4 + wr;
            const int inner = (4 * wc + fq) * 1024 + fr * 16;
#pragma unroll
            for (int bj = 0; bj < 2; ++bj) { const int h = (u.pn & 3) * 2 + bj;
#pragma unroll
                for (int ai = 0; ai < 2; ++ai) { unsigned char* img = KV + ((size_t)((b * 8 + h) * 128 + t0 + 2 * ai) << 15) + inner;
#pragma unroll
                    for (int m = 0; m < 4; ++m) { const f32x4 v0 = acc[ai][bj][m][0], v1 = acc[ai][bj][m][1];
                        u32x4 w; w.x = cvt_pk_bf16(v0[0], v0[1]); w.y = cvt_pk_bf16(v0[2], v0[3]); w.z = cvt_pk_bf16(v1[0], v1[1]); w.w = cvt_pk_bf16(v1[2], v1[3]);
                        *(u32x4*)(img + m * 256) = w; } } }
        } else {
            const int b = u.pm >> 5, t0 = (u.pm & 31) * 4 + wr;
            const int inner = 16384 + wc * 4096 + ((fr >> 2) & 1) * 512 + (8 * fq) * 16 + ((fr & 3) + 4 * (fr >> 3)) * 2;
#pragma unroll
            for (int bj = 0; bj < 2; ++bj) { const int h = (u.pn & 3) * 2 + bj;
#pragma unroll
                for (int ai = 0; ai < 2; ++ai) { unsigned char* img = KV + ((size_t)((b * 8 + h) * 128 + t0 + 2 * ai) << 15) + inner;
#pragma unroll
                    for (int m = 0; m < 4; ++m) { const f32x4 v0 = acc[ai][bj][m][0], v1 = acc[ai][bj][m][1];
                        const unsigned w0 = cvt_pk_bf16(v0[0], v0[1]), w1 = cvt_pk_bf16(v0[2], v0[3]), w2 = cvt_pk_bf16(v1[0], v1[1]), w3 = cvt_pk_bf16(v1[2], v1[3]);
                        unsigned short* p = (unsigned short*)(img + m * 1024);
                        p[0 * 8] = (unsigned short)w0; p[1 * 8] = (unsigned short)(w0 >> 16); p[2 * 8] = (unsigned short)w1; p[3 * 8] = (unsigned short)(w1 >> 16);
                        p[4 * 8] = (unsigned short)w2; p[5 * 8] = (unsigned short)(w2 >> 16); p[6 * 8] = (unsigned short)w3; p[7 * 8] = (unsigned short)(w3 >> 16); } } }
        }
    }
};
struct EpiConvGate {
    static constexpr bool PERM = true, AFTER_DRAIN = false;
    bf16_t* Vb; bf16_t* Gb;
    __device__ __forceinline__ void operator()(const f32x4 (&acc)[2][2][4][2], const Unit& u, int wr, int wc, int fr, int fq) const {
        const int row0 = u.pm * BM + wr * 64 + fr;
        const bool isg = wc >= 2;
        bf16_t* base = (isg ? Gb : Vb) + u.pn * 64 + (wc & 1) * 32 + 8 * fq;
#pragma unroll
        for (int ai = 0; ai < 2; ++ai)
#pragma unroll
            for (int m = 0; m < 4; ++m) { bf16_t* rowp = base + (size_t)(row0 + ai * HALF + m * 16) * 1024;
                f32x4 a0 = acc[ai][0][m][0], a1 = acc[ai][0][m][1], b0 = acc[ai][1][m][0], b1 = acc[ai][1][m][1];
                if (isg) {
#pragma unroll
                    for (int e = 0; e < 4; ++e) { b0[e] = silu_f(b0[e]); b1[e] = silu_f(b1[e]); }
                }
                const f32x4 v0 = a0 * b0, v1 = a1 * b1;
                u32x4 w; w.x = cvt_pk_bf16(v0[0], v0[1]); w.y = cvt_pk_bf16(v0[2], v0[3]); w.z = cvt_pk_bf16(v1[0], v1[1]); w.w = cvt_pk_bf16(v1[2], v1[3]);
                *(u32x4*)rowp = w; }
    }
};
struct EpiRes {
    static constexpr bool PERM = false, AFTER_DRAIN = false;
    const float* base; float* out; int ldc;
    __device__ __forceinline__ void operator()(const f32x4 (&acc)[2][2][4][2], const Unit& u, int wr, int wc, int fr, int fq) const {
        const int col0 = u.pn * BM + wc * 32 + 4 * fq;
#pragma unroll
        for (int ai = 0; ai < 2; ++ai) {
            const size_t off0 = (size_t)(u.pm * BM + ai * HALF + wr * 64 + fr) * ldc + col0;
            f32x4 pre[4][2][2];
#pragma unroll
            for (int m = 0; m < 4; ++m)
#pragma unroll
                for (int bj = 0; bj < 2; ++bj)
#pragma unroll
                    for (int n = 0; n < 2; ++n) pre[m][bj][n] = *(const f32x4*)(base + off0 + (size_t)(m * 16) * ldc + bj * HALF + n * 16);
#pragma unroll
            for (int m = 0; m < 4; ++m)
#pragma unroll
                for (int bj = 0; bj < 2; ++bj)
#pragma unroll
                    for (int n = 0; n < 2; ++n) *(f32x4*)(out + off0 + (size_t)(m * 16) * ldc + bj * HALF + n * 16) = pre[m][bj][n] + acc[ai][bj][m][n];
            asm volatile("" ::: "memory");
        }
    }
};

template <class Epi, class Sched, bool ALIGN_EPI = false, bool SP2 = false>
__device__ __forceinline__ void gemm_phase(PG8_LAS unsigned char* lds, const Gemm g, const Sched& S, const Epi& E) {
    const int tid = fresh_tid(), wid = __builtin_amdgcn_readfirstlane(tid >> 6), lane = tid & 63, wr = wid >> 2, wc = wid & 3, fr = lane & 15, fq = lane >> 4;
    const int K = g.K, nt = K / BK;
    unsigned voffA[2], voffB[2];
#pragma unroll
    for (int i = 0; i < 2; ++i) { int R, C; stage_rc(tid * 16 + i * 8192, R, C); const int Rb = Epi::PERM ? ((R & ~31) + perm32(R & 31)) : R;
        voffA[i] = (unsigned)(R * K + C) * 2u; voffB[i] = (unsigned)(Rb * K + C) * 2u; }
    const size_t kstep = (size_t)(BK * 2);
    const size_t hstep = (size_t)HALF * K * 2;
    const size_t tstep = 2 * hstep;
    const unsigned ldsw = (unsigned)wid * 1024u;
    const int aoff = lds_byte(wr * 64 + fr, fq * 8), boff = lds_byte(wc * 32 + fr, fq * 8);
#define PG8_SA(b, h) (((b) * 2 + (h)) * HTB)
#define PG8_SB(b, h) ((4 + (b) * 2 + (h)) * HTB)
#define PG8_STAGE(bufoff, gbase, voff) do { _Pragma("unroll") for (int _i = 0; _i < 2; ++_i) \
        __builtin_amdgcn_global_load_lds((const unsigned*)((const char*)(gbase) + (voff)[_i]), (PG8_LAS unsigned*)(lds + (bufoff) + ldsw + _i * 8192), 16, 0, 0); } while (0)
#define PG8_LDA(dst, b, h) do { _Pragma("unroll") for (int m = 0; m < 4; ++m) _Pragma("unroll") for (int k = 0; k < 2; ++k) dst[m][k] = *(const PG8_LAS bf16x8*)(lds + PG8_SA(b, h) + aoff + m * 2048 + k * 1024); } while (0)
#define PG8_LDB(dst, b, h) do { _Pragma("unroll") for (int n = 0; n < 2; ++n) _Pragma("unroll") for (int k = 0; k < 2; ++k) dst[n][k] = *(const PG8_LAS bf16x8*)(lds + PG8_SB(b, h) + boff + n * 2048 + k * 1024); } while (0)
#define PG8_MMA(ai, bj, At, Bt) do { __builtin_amdgcn_s_setprio(1); _Pragma("unroll") for (int m = 0; m < 4; ++m) _Pragma("unroll") for (int n = 0; n < 2; ++n) _Pragma("unroll") for (int k = 0; k < 2; ++k) \
        acc[ai][bj][m][n] = __builtin_amdgcn_mfma_f32_16x16x32_bf16(Bt[n][k], At[m][k], acc[ai][bj][m][n], 0, 0, 0); __builtin_amdgcn_s_setprio(0); } while (0)
#define PG8_WAIT_V(n) asm volatile("s_waitcnt vmcnt(" #n ")" ::: "memory")
#define PG8_WAIT_L(n) asm volatile("s_waitcnt lgkmcnt(" #n ")" ::: "memory")
#define PG8_BAR __builtin_amdgcn_s_barrier()
#define PG8_SCHED __builtin_amdgcn_sched_barrier(0)
    Unit cur, nxt; int ui = 0;
    if (!S.next(0, cur)) return;
    f32x4 acc[2][2][4][2];
#pragma unroll
    for (int a = 0; a < 2; ++a)
#pragma unroll
        for (int b = 0; b < 2; ++b)
#pragma unroll
            for (int m = 0; m < 4; ++m)
#pragma unroll
                for (int n = 0; n < 2; ++n) acc[a][b][m][n] = (f32x4){0.f, 0.f, 0.f, 0.f};
    bf16x8 At[4][2], B0[2][2], B1[2][2];
    const char* cA = (const char*)g.A + (size_t)cur.pm * tstep; const char* cB = (const char*)g.Bt + (size_t)cur.pn * tstep;
    S.a_ready(cur);
    if constexpr (SP2) {
        PG8_STAGE(PG8_SB(0, 0), cB, voffB); PG8_STAGE(PG8_SB(0, 1), cB + hstep, voffB); PG8_STAGE(PG8_SA(0, 0), cA, voffA); PG8_STAGE(PG8_SA(0, 1), cA + hstep, voffA);
        if (wr == 1) PG8_BAR;
        PG8_WAIT_V(2); PG8_BAR;
        PG8_STAGE(PG8_SB(1, 0), cB + kstep, voffB); PG8_STAGE(PG8_SA(1, 0), cA + kstep, voffA); PG8_STAGE(PG8_SB(1, 1), cB + hstep + kstep, voffB);
        PG8_WAIT_V(6); PG8_BAR;
    } else {
        PG8_STAGE(PG8_SB(0, 0), cB, voffB); PG8_STAGE(PG8_SA(0, 0), cA, voffA); PG8_STAGE(PG8_SB(0, 1), cB + hstep, voffB); PG8_STAGE(PG8_SA(0, 1), cA + hstep, voffA);
        if (wr == 1) PG8_BAR;
        PG8_WAIT_V(4); PG8_BAR;
        PG8_STAGE(PG8_SB(1, 0), cB + kstep, voffB); PG8_STAGE(PG8_SA(1, 0), cA + kstep, voffA); PG8_STAGE(PG8_SB(1, 1), cB + hstep + kstep, voffB);
        PG8_WAIT_V(6); PG8_BAR;
    }
    for (;;) {
        const bool has_next = S.next(ui + 1, nxt);
        const char* nA = has_next ? (const char*)g.A + (size_t)nxt.pm * tstep : cA; const char* nB = has_next ? (const char*)g.Bt + (size_t)nxt.pn * tstep : cB;
        for (int t = 0; t < nt; t += 2) {
            const bool last = (t == nt - 2);
            const char* a1 = cA + (size_t)(t + 1) * kstep;
            const char* a2 = last ? nA : cA + (size_t)(t + 2) * kstep; const char* b2 = last ? nB : cB + (size_t)(t + 2) * kstep;
            const char* a3 = a2 + kstep; const char* b3 = b2 + kstep;
            if (last && has_next) S.a_ready(nxt);
            if constexpr (SP2) {
            PG8_LDB(B0, 0, 0); PG8_LDB(B1, 0, 1); PG8_SCHED; PG8_LDA(At, 0, 0); PG8_STAGE(PG8_SA(1, 1), a1 + hstep, voffA);
            PG8_WAIT_V(8); PG8_WAIT_L(0); PG8_BAR; PG8_MMA(0, 0, At, B0); PG8_MMA(0, 1, At, B1); PG8_BAR; PG8_SCHED;
            PG8_LDA(At, 0, 1); PG8_STAGE(PG8_SB(0, 0), b2, voffB); PG8_STAGE(PG8_SB(0, 1), b2 + hstep, voffB); PG8_STAGE(PG8_SA(0, 0), a2, voffA);
            PG8_WAIT_V(8); PG8_WAIT_L(0); PG8_BAR; PG8_MMA(1, 0, At, B0); PG8_MMA(1, 1, At, B1); PG8_BAR; PG8_SCHED;
            PG8_LDB(B0, 1, 0); PG8_LDB(B1, 1, 1); PG8_SCHED; PG8_LDA(At, 1, 0); PG8_STAGE(PG8_SA(0, 1), a2 + hstep, voffA);
            PG8_WAIT_V(8); PG8_WAIT_L(0); PG8_BAR; PG8_MMA(0, 0, At, B0); PG8_MMA(0, 1, At, B1); PG8_BAR; PG8_SCHED;
            PG8_LDA(At, 1, 1); PG8_STAGE(PG8_SB(1, 0), b3, voffB); PG8_STAGE(PG8_SB(1, 1), b3 + hstep, voffB); PG8_STAGE(PG8_SA(1, 0), a3, voffA);
            PG8_WAIT_V(8); PG8_WAIT_L(0); PG8_BAR; PG8_MMA(1, 0, At, B0); PG8_MMA(1, 1, At, B1); PG8_BAR; PG8_SCHED;
            } else {
            PG8_LDB(B0, 0, 0); PG8_SCHED; PG8_LDA(At, 0, 0); PG8_STAGE(PG8_SA(1, 1), a1 + hstep, voffA);
            PG8_WAIT_L(8); PG8_BAR; PG8_WAIT_L(0); PG8_MMA(0, 0, At, B0); PG8_BAR; PG8_SCHED;
            PG8_LDB(B1, 0, 1); PG8_STAGE(PG8_SB(0, 0), b2, voffB);
            PG8_BAR; PG8_WAIT_L(0); PG8_MMA(0, 1, At, B1); PG8_BAR;
            PG8_LDA(At, 0, 1); PG8_STAGE(PG8_SA(0, 0), a2, voffA);
            PG8_BAR; PG8_WAIT_L(0); PG8_MMA(1, 0, At, B0); PG8_BAR; PG8_SCHED;
            PG8_STAGE(PG8_SB(0, 1), b2 + hstep, voffB);
            PG8_WAIT_V(6); PG8_BAR; PG8_MMA(1, 1, At, B1); PG8_BAR;
            PG8_LDB(B0, 1, 0); PG8_SCHED; PG8_LDA(At, 1, 0); PG8_STAGE(PG8_SA(0, 1), a2 + hstep, voffA);
            PG8_WAIT_L(8); PG8_BAR; PG8_WAIT_L(0); PG8_MMA(0, 0, At, B0); PG8_BAR; PG8_SCHED;
            PG8_LDB(B1, 1, 1); PG8_STAGE(PG8_SB(1, 0), b3, voffB);
            PG8_BAR; PG8_WAIT_L(0); PG8_MMA(0, 1, At, B1); PG8_BAR;
            PG8_LDA(At, 1, 1); PG8_STAGE(PG8_SA(1, 0), a3, voffA);
            PG8_BAR; PG8_WAIT_L(0); PG8_MMA(1, 0, At, B0); PG8_BAR; PG8_SCHED;
            PG8_STAGE(PG8_SB(1, 1), b3 + hstep, voffB);
            PG8_WAIT_V(6); PG8_BAR; PG8_MMA(1, 1, At, B1); PG8_BAR;
            }
        }
        if constexpr (ALIGN_EPI) { if (wr == 0) PG8_BAR; }
        if constexpr (!Epi::AFTER_DRAIN) { E(acc, cur, wr, wc, fr, fq); S.done(cur); }
        if (!has_next) break;
#pragma unroll
        for (int a = 0; a < 2; ++a)
#pragma unroll
            for (int b = 0; b < 2; ++b)
#pragma unroll
                for (int m = 0; m < 4; ++m)
#pragma unroll
                    for (int n = 0; n < 2; ++n) acc[a][b][m][n] = (f32x4){0.f, 0.f, 0.f, 0.f};
        cur = nxt; cA = nA; cB = nB; ++ui;
        if constexpr (ALIGN_EPI) { if (wr == 1) PG8_BAR; }
    }
    PG8_WAIT_V(0);
    if constexpr (!ALIGN_EPI) { if (wr == 0) PG8_BAR; }
    PG8_BAR;
    if constexpr (Epi::AFTER_DRAIN) { E.fused(acc, cur, wr, wc, fr, fq, lds, wid, lane); S.done(cur); }
#undef PG8_SA
#undef PG8_SB
#undef PG8_STAGE
#undef PG8_LDA
#undef PG8_LDB
#undef PG8_MMA
#undef PG8_WAIT_V
#undef PG8_WAIT_L
#undef PG8_BAR
#undef PG8_SCHED
}
}

namespace attn_body {
using bf16x8=__attribute__((ext_vector_type(8)))short;
using s16x4=__attribute__((ext_vector_type(4)))short;
using f32x16=__attribute__((ext_vector_type(16)))float;
using u32x4=__attribute__((ext_vector_type(4)))unsigned;
using f32x4g=__attribute__((ext_vector_type(4)))float;
typedef unsigned short bf16raw;
constexpr int SEQ=8192,PITCH=2048,YP=1024,NHEAD=8;
constexpr int NW=8,QBLK=32,QB=128,KVBLK=64,NQB=SEQ/QB;
constexpr int SLOT16=16384;
constexpr int LDS_KR=0,LDS_VR=3*SLOT16;
constexpr int LDS_WS=6*SLOT16, LDS_BIAS=LDS_WS+NW*64*4, LDS_DUMMY=LDS_BIAS+2048, LDS_BYTES=LDS_DUMMY+16384;
constexpr float LOG2E=1.4426950408889634f;
constexpr float C2=0.125f*LOG2E;
__device__ __forceinline__ int crow(int r,int hi){return (r&3)+8*(r>>2)+4*hi;}
#define SBAR() __builtin_amdgcn_sched_barrier(0)
__device__ __forceinline__ void glds16(const void*gsrc,unsigned lds_dst){unsigned keep;
  asm volatile("s_mov_b32 %0, m0\n\ts_mov_b32 m0, %2\n\ts_nop 0\n\tglobal_load_lds_dwordx4 %1, off\n\ts_mov_b32 m0, %0":"=&s"(keep):"v"(gsrc),"s"(lds_dst):"memory");}
__device__ __forceinline__ void glds16s(const void*sbase,unsigned voff,unsigned lds_dst){unsigned keep;
  asm volatile("s_mov_b32 %0, m0\n\ts_mov_b32 m0, %3\n\ts_nop 0\n\tglobal_load_lds_dwordx4 %2, %1\n\ts_mov_b32 m0, %0":"=&s"(keep):"s"(sbase),"v"(voff),"s"(lds_dst):"memory");}
typedef float f32x2_t __attribute__((ext_vector_type(2))); typedef __bf16 bf16x2_t __attribute__((ext_vector_type(2)));
__device__ __forceinline__ unsigned cvtpk_s(float lo,float hi){f32x2_t v={lo,hi};bf16x2_t b=__builtin_convertvector(v,bf16x2_t);return __builtin_bit_cast(unsigned,b);}
__device__ __forceinline__ float bf2f(bf16raw v){return __uint_as_float(((unsigned)v)<<16);}
#define WAIT_BAR(N) asm volatile("s_waitcnt vmcnt(" #N ") lgkmcnt(0)\n\ts_barrier":::"memory")
typedef __attribute__((address_space(3))) const char* lds_cptr;
typedef short v4i16_t __attribute__((ext_vector_type(4)));
__device__ __forceinline__ s16x4 vtr(lds_cptr p){ return __builtin_bit_cast(s16x4,__builtin_amdgcn_ds_read_tr16_b64_v4i16((__attribute__((address_space(3))) v4i16_t*)p)); }
__device__ __forceinline__ int t5_bucket(int d){ if(d<16)return d; int b=16+(int)(__builtin_log2f((float)d*(1.0f/16.0f))*(16.0f/3.0f)); return b>31?31:b; }

__device__ __forceinline__ void qkt(f32x16&p0,f32x16&p1,lds_cptr kb,const bf16x8*qr){
  const f32x16 z=f32x16{};
  #pragma unroll
  for(int d0=0;d0<4;++d0){
    const bf16x8 b0=*(const __attribute__((address_space(3))) bf16x8*)(kb+d0*2048);
    const bf16x8 b1=*(const __attribute__((address_space(3))) bf16x8*)(kb+d0*2048+512);
    if(d0==0){p0=__builtin_amdgcn_mfma_f32_32x32x16_bf16(b0,qr[0],z,0,0,0);p1=__builtin_amdgcn_mfma_f32_32x32x16_bf16(b1,qr[0],z,0,0,0);}
    else{p0=__builtin_amdgcn_mfma_f32_32x32x16_bf16(b0,qr[d0],p0,0,0,0);p1=__builtin_amdgcn_mfma_f32_32x32x16_bf16(b1,qr[d0],p1,0,0,0);}}
}
__device__ __forceinline__ float rowmax(const f32x16&p0,const f32x16&p1){
  float a=p0[0];
  #pragma unroll
  for(int r=1;r<16;++r)a=__builtin_fmaxf(a,p0[r]);
  float c=p1[0];
  #pragma unroll
  for(int r=1;r<16;++r)c=__builtin_fmaxf(c,p1[r]);
  a=__builtin_fmaxf(a,c);
  auto rr=__builtin_amdgcn_permlane32_swap(__float_as_uint(a),__float_as_uint(a),false,false);
  return __builtin_fmaxf(__uint_as_float(rr[0]),__uint_as_float(rr[1]));
}

struct AttnArgs { const bf16raw* P; const unsigned char* KV; bf16raw* Y; const float* relb; const float* subg; float lam; float onem; };

template<int THRL> __device__ __forceinline__ void attn_unit(int b,int h,int qb,const AttnArgs&A,char*shm,bool setup){
  const int tid=fresh_tid(),lane=tid&63,r32=lane&31,hi=lane>>5; const int wid=__builtin_amdgcn_readfirstlane(tid>>6);
  const int rg=wid&3,mp=wid>>2;
  const long rowbase=(long)b*SEQ; const int q0=qb*QB; const int qw0=q0+rg*QBLK;
  const bf16raw*Qw=A.P+(rowbase+qw0)*PITCH+(2*h+mp)*64;
  const unsigned char*imgS=A.KV+((size_t)((b*NHEAD+h)*(SEQ/KVBLK))<<15);
  const unsigned voff=(unsigned)(wid*1024+lane*16);
  const unsigned lds0=(unsigned)(uintptr_t)shm;
  float*wsf=(float*)(shm+LDS_WS)+wid*64;
  float*biasT=(float*)(shm+LDS_BIAS);
  float*xch=(float*)shm+rg*4096+lane;
  const lds_cptr shm3=(lds_cptr)shm;
  float*subgT=biasT+256;
  if(setup){
    if(tid<256){ const int m_=tid>>7,d=tid&127; biasT[tid]=A.relb[t5_bucket(d)*16+2*h+m_]*LOG2E; }
    else if(tid<384){ subgT[tid-256]=A.subg[tid-256]*A.onem; }
    asm volatile("s_waitcnt vmcnt(0) lgkmcnt(0)\n\ts_barrier":::"memory");
  }
  const float cfar=biasT[mp*128+127];
  const unsigned kdst=lds0+LDS_KR+wid*1024, vdst=lds0+LDS_VR+wid*1024, ddst=lds0+LDS_DUMMY+wid*1024;
  #define DMA_K(t,slot) do{ const unsigned char*g_=imgS+((size_t)(t)<<15); \
      glds16s(g_,voff,(unsigned)__builtin_amdgcn_readfirstlane(kdst+(slot))); glds16s(g_+8192,voff,(unsigned)__builtin_amdgcn_readfirstlane(kdst+(slot)+8192)); }while(0)
  #define DMA_V(t,slot) do{ const unsigned char*g_=imgS+((size_t)(t)<<15)+16384; \
      glds16s(g_,voff,(unsigned)__builtin_amdgcn_readfirstlane(vdst+(slot))); glds16s(g_+8192,voff,(unsigned)__builtin_amdgcn_readfirstlane(vdst+(slot)+8192)); }while(0)
  const lds_cptr kp0=shm3+LDS_KR+mp*8192+hi*1024+r32*16;
  const lds_cptr vp0=shm3+LDS_VR+hi*512+r32*16;
  const int NT=(q0+QB)/KVBLK;
  bf16x8 qr[4];
  #pragma unroll
  for(int d0=0;d0<4;++d0)qr[d0]=*reinterpret_cast<const bf16x8*>(&Qw[(long)r32*PITCH+d0*16+hi*8]);
  DMA_K(0,0); DMA_V(0,0); DMA_K(1,SLOT16);
  DMA_V(1,SLOT16); { const unsigned char*g_=imgS+((size_t)(NT>2?2:NT-1)<<15); const unsigned d_=(unsigned)__builtin_amdgcn_readfirstlane(NT>2?kdst+2*SLOT16:ddst); glds16s(g_,voff,d_); glds16s(g_+8192,voff,d_+8192); }
  float mhat=0.f,l=0.f;
  f32x16 o[4];
  #pragma unroll
  for(int d0=0;d0<4;++d0)o[d0]=f32x16{};
  const int qpos=qw0+r32;
  f32x16 p0,p1; u32x4 pw[4]; bf16x8 kf[8]; bf16x8 va[4],vb[4];
  f32x16 cini;
  #pragma unroll
  for(int r=0;r<16;++r)cini[r]=cfar;
  asm volatile("":"+v"(cini));
  #define LDK(kp_,o_) (*(const __attribute__((address_space(3))) bf16x8*)((kp_)+(o_)))
  #define KRD(kp_) do{ _Pragma("unroll") for(int d0_=0;d0_<4;++d0_){ kf[2*d0_]=LDK(kp_,d0_*2048); kf[2*d0_+1]=LDK(kp_,d0_*2048+512); } }while(0)
  #define QKM(z_) do{ \
      p0=__builtin_amdgcn_mfma_f32_32x32x16_bf16(kf[0],qr[0],z_,0,0,0); \
      _Pragma("unroll") for(int d0_=1;d0_<4;++d0_){ p0=__builtin_amdgcn_mfma_f32_32x32x16_bf16(kf[2*d0_],qr[d0_],p0,0,0,0); } \
      p1=__builtin_amdgcn_mfma_f32_32x32x16_bf16(kf[1],qr[0],z_,0,0,0); \
      _Pragma("unroll") for(int d0_=1;d0_<4;++d0_){ p1=__builtin_amdgcn_mfma_f32_32x32x16_bf16(kf[2*d0_+1],qr[d0_],p1,0,0,0); } }while(0)
  #define VRK(dst,vp_,ks_) do{ _Pragma("unroll") for(int d0_=0;d0_<4;++d0_){ dst[d0_]=*(const __attribute__((address_space(3))) bf16x8*)((vp_)+d0_*4096+(ks_)*1024); } }while(0)
  #define VFR(src,ks_) (bf16x8){src[2*(ks_)][0],src[2*(ks_)][1],src[2*(ks_)][2],src[2*(ks_)][3],src[2*(ks_)+1][0],src[2*(ks_)+1][1],src[2*(ks_)+1][2],src[2*(ks_)+1][3]}
  #define PVM(d0_,src) do{ _Pragma("unroll") for(int ks_=0;ks_<4;++ks_) o[d0_]=__builtin_amdgcn_mfma_f32_32x32x16_bf16(__builtin_bit_cast(bf16x8,pw[ks_]),VFR(src,ks_),o[d0_],0,0,0); }while(0)
  WAIT_BAR(8);
  KRD(kp0);
  int ks_t=0,ks_n=SLOT16,vs_t=0,vs_nn=2*SLOT16;
  for(int t=0;t<NT;++t){
    WAIT_BAR(4);
    const int kv0=t*KVBLK;
    const bool act=(kv0<=qw0+QBLK-1);
    const bool actn=(t+1<NT)&&(kv0+KVBLK<=qw0+QBLK-1);
    const lds_cptr vp=vp0+vs_t;
    const bool dk=(t+3<NT), dv=(t+2<NT);
    const unsigned char*gk_=imgS+((size_t)(dk?t+3:NT-1)<<15); const unsigned char*gv_=imgS+((size_t)(dv?t+2:NT-1)<<15)+16384;
    const unsigned kd_=(unsigned)__builtin_amdgcn_readfirstlane(dk?kdst+ks_t:ddst), vd_=(unsigned)__builtin_amdgcn_readfirstlane(dv?vdst+vs_nn:ddst);
    if(act){
      VRK(va,vp,0); VRK(vb,vp,1);
      SBAR();
      if(qw0-(kv0+63)>=113){ QKM(cini); } else { const f32x16 z0_=f32x16{}; QKM(z0_); }
    }
    if(act){
      const bool far=(qw0-(kv0+63)>=113);
      if(!far){ const float*bt=biasT+mp*128; const int dq=qpos-kv0-4*hi;
        #pragma unroll
        for(int r=0;r<16;++r){ const int d=dq-((r&3)+8*(r>>2));
          const int i0=d<0?0:(d>127?127:d);
          const float b0=bt[i0];
          const float n0=d>=0?0.f:-INFINITY;
          p0[r]=(p0[r]+(b0-mhat))+n0; if((r&7)==7)asm volatile("":::"memory"); }
        #pragma unroll
        for(int r=0;r<16;++r){ const int d1=dq-32-((r&3)+8*(r>>2));
          const int i1=d1<0?0:(d1>127?127:d1);
          const float b1=bt[i1];
          const float n1=d1>=0?0.f:-INFINITY;
          p1[r]=(p1[r]+(b1-mhat))+n1; if((r&7)==7)asm volatile("":::"memory"); } }
      const float rm=rowmax(p0,p1);
      if(t==0||__any(rm>(float)THRL)){
        const float dl=(t==0)?rm:__builtin_fmaxf(rm,0.f);
        #pragma unroll
        for(int r=0;r<16;++r){p0[r]-=dl;p1[r]-=dl;}
        if(t>0){ const float f=__builtin_amdgcn_exp2f(-dl);
          l*=f;
          #pragma unroll
          for(int d0=0;d0<4;++d0)
            #pragma unroll
            for(int r=0;r<16;++r)o[d0][r]*=f; }
        mhat+=dl;
        { const float ci=cfar-mhat;
          #pragma unroll
          for(int r=0;r<16;++r)cini[r]=ci;
          asm volatile("":"+v"(cini)); }
      }
      #define EX2(P,B) do{ P[B]=__builtin_amdgcn_exp2f(P[B]); P[B+1]=__builtin_amdgcn_exp2f(P[B+1]); sacc+=P[B]; sacc+=P[B+1]; }while(0)
      #define QTR(P,B,W,I) do{ EX2(P,B); asm volatile("":"+v"(sacc)); { unsigned w_=cvtpk_s(P[B],P[B+1]); asm volatile("":"+v"(w_)); W[I]=w_; } }while(0)
      #define PV1(d0_,ks_,src) o[d0_]=__builtin_amdgcn_mfma_f32_32x32x16_bf16(src[d0_],__builtin_bit_cast(bf16x8,pw[ks_]),o[d0_],0,0,0)
      float sacc=0.f;
      QTR(p0,0,pw[0],0); QTR(p0,2,pw[0],1); QTR(p0,4,pw[0],2); QTR(p0,6,pw[0],3);
      SBAR();
      PV1(0,0,va); QTR(p0,8,pw[1],0);  SBAR();
      PV1(1,0,va); QTR(p0,10,pw[1],1); SBAR();
      PV1(2,0,va); QTR(p0,12,pw[1],2); SBAR();
      PV1(3,0,va); QTR(p0,14,pw[1],3); SBAR();
      VRK(va,vp,2); SBAR();
      PV1(0,1,vb); QTR(p1,0,pw[2],0);  SBAR();
      PV1(1,1,vb); QTR(p1,2,pw[2],1);  SBAR();
      PV1(2,1,vb); QTR(p1,4,pw[2],2);  SBAR();
      PV1(3,1,vb); QTR(p1,6,pw[2],3);  SBAR();
      VRK(vb,vp,3); SBAR();
      PV1(0,2,va); QTR(p1,8,pw[3],0);  SBAR();
      PV1(1,2,va); QTR(p1,10,pw[3],1); SBAR();
      PV1(2,2,va); QTR(p1,12,pw[3],2); SBAR();
      PV1(3,2,va); QTR(p1,14,pw[3],3); SBAR();
      KRD(kp0+ks_n); SBAR();
      PV1(0,3,vb); PV1(1,3,vb); PV1(2,3,vb); PV1(3,3,vb);
      l+=sacc;
      SBAR();
      #undef EX2
      #undef QTR
      #undef PV1
    }
    glds16s(gk_,voff,kd_); glds16s(gk_+8192,voff,kd_+8192); glds16s(gv_,voff,vd_); glds16s(gv_+8192,voff,vd_+8192);
    ks_t=ks_n; ks_n=(ks_n==2*SLOT16)?0:ks_n+SLOT16; vs_t=(vs_t==2*SLOT16)?0:vs_t+SLOT16; vs_nn=(vs_nn==2*SLOT16)?0:vs_nn+SLOT16;
  }
  #undef LDK
  #undef KRD
  #undef QKM
  #undef VRD
  #undef VRK
  #undef VFR
  #undef PVM
  {auto rr=__builtin_amdgcn_permlane32_swap(__float_as_uint(l),__float_as_uint(l),false,false);l=__uint_as_float(rr[0])+__uint_as_float(rr[1]);}
  const float ascl=(mp?A.lam:1.0f)/l;
  typedef unsigned u32x2e __attribute__((ext_vector_type(2)));
  u32x2e zq[4][4];
  const long orow=rowbase+qw0+r32;
  if(mp==0){
    const bf16raw*zp=A.P+orow*PITCH+1024+h*128+4*hi;
    #pragma unroll
    for(int d0=0;d0<4;++d0)
      #pragma unroll
      for(int g=0;g<4;++g)zq[d0][g]=*(const u32x2e*)(zp+d0*32+8*g);
  }
  asm volatile("s_waitcnt lgkmcnt(0)\n\ts_barrier":::"memory");
  if(mp==1){
    #pragma unroll
    for(int r=0;r<16;++r)
      #pragma unroll
      for(int d0=0;d0<4;++d0)xch[(d0*16+r)*64]=o[d0][r]*ascl;
  }
  asm volatile("s_waitcnt lgkmcnt(0)\n\ts_barrier":::"memory");
  if(mp==0){
    float ss=0.f;
    #pragma unroll
    for(int r=0;r<16;++r)
      #pragma unroll
      for(int d0=0;d0<4;++d0){ const float v_=o[d0][r]*ascl-xch[(d0*16+r)*64]; o[d0][r]=v_; ss+=v_*v_; }
    {auto rr=__builtin_amdgcn_permlane32_swap(__float_as_uint(ss),__float_as_uint(ss),false,false);ss=__uint_as_float(rr[0])+__uint_as_float(rr[1]);}
    const float rstd=__builtin_amdgcn_rsqf(ss*(1.0f/128.0f)+1e-6f);
    bf16raw*yp=A.Y+orow*YP+h*128+4*hi;
    #pragma unroll
    for(int d0=0;d0<4;++d0)
      #pragma unroll
      for(int g=0;g<4;++g){
        const f32x4g gs=*(const f32x4g*)(subgT+d0*32+8*g+4*hi);
        float y[4];
        #pragma unroll
        for(int e=0;e<4;++e){ const unsigned zw=(e<2)?zq[d0][g][0]:zq[d0][g][1]; const float z=__uint_as_float((e&1)?(zw&0xffff0000u):(zw<<16));
          const float sg=z*__builtin_amdgcn_rcpf(1.0f+__builtin_amdgcn_exp2f(-LOG2E*z)); y[e]=o[d0][4*g+e]*rstd*gs[e]*sg; }
        u32x2e w; w[0]=cvtpk_s(y[0],y[1]); w[1]=cvtpk_s(y[2],y[3]);
        *(u32x2e*)(yp+d0*32+8*g)=w; }
  }
  WAIT_BAR(0);
  #undef DMA_K
  #undef DMA_V
}
#undef WAIT_BAR
#undef SBAR
}

constexpr int NWAVES = 8;
constexpr int PROBE_ATTN_REP = 1;
constexpr int BATCH = 4, T = 8192, D = 1024, DEPTH = 4, NP = 4 * D;
constexpr int M = BATCH * T;
constexpr float RMS_EPS = 1e-6f;
constexpr size_t MiB = 1u << 20;
constexpr size_t WS_WIN = 2 * MiB;
constexpr size_t WS_WOUT = 34 * MiB;
constexpr size_t WS_XN = 48 * MiB;
constexpr size_t WS_Y = 112 * MiB;
constexpr size_t WS_P = 176 * MiB;
constexpr size_t WS_END = 432 * MiB;
constexpr int RING_BYTES = 131072;
constexpr int LDS_BYTES = 147456;
static_assert(attn_body::LDS_BYTES <= RING_BYTES, "attention LDS");

#define GAS __attribute__((address_space(1)))
#define LAS __attribute__((address_space(3)))
typedef unsigned short bf16;
typedef unsigned v4u __attribute__((ext_vector_type(4)));
typedef float f32x4 __attribute__((ext_vector_type(4)));
#define LDS_WAIT() asm volatile("s_waitcnt lgkmcnt(0)" ::: "memory")
__device__ __forceinline__ unsigned f2bf(float f) { unsigned u = __builtin_bit_cast(unsigned, f); return (u + 0x7fffu + ((u >> 16) & 1u)) >> 16; }
__device__ __forceinline__ unsigned pk2(float lo, float hi) { return f2bf(lo) | (f2bf(hi) << 16); }
__device__ __forceinline__ float wave_sum(float v) { return wave_sum64(v); }
__device__ __forceinline__ void p0_transpose_item(const float* W, int K, int N, bf16* WT, int conv, LAS float* scrf, int item, int lane, const float* gk) {
    LAS unsigned short* scr = (LAS unsigned short*)scrf;
    constexpr int TP = 68;
    const int nblk = N / 64, kb = item / nblk, nb = item % nblk, k0 = 64 * kb, n0 = 64 * nb;
    const int lr = lane >> 4, lc = (lane & 15) * 4;
    f32x4 v[16];
#pragma unroll
    for (int i = 0; i < 16; ++i) v[i] = *(const GAS f32x4*)(W + (size_t)(k0 + 4 * i + lr) * N + n0 + lc);
#pragma unroll
    for (int i = 0; i < 16; ++i) { const float g_ = gk ? gk[k0 + 4 * i + lr] : 1.0f; const f32x4 y = v[i] * g_;
        *(LAS unsigned long long*)(scr + (4 * i + lr) * TP + lc) = (unsigned long long)pk2(y.x, y.y) | ((unsigned long long)pk2(y.z, y.w) << 32); }
    LDS_WAIT(); asm volatile("" ::: "memory");
    int dn0 = n0;
    if (conv) { const int part = n0 >> 10, ch = n0 & 1023, pn = ch >> 6; const int slot = (part == 0) ? 1 : (part == 1) ? 0 : part; dn0 = 256 * pn + 64 * slot; }
    const int c = lane & 7;
#pragma unroll
    for (int j = 0; j < 8; ++j) { const int n = (lane >> 3) + 8 * j; const LAS unsigned short* s_ = scr + (8 * c) * TP + n;
        v4u o; o.x = (unsigned)s_[0 * TP] | ((unsigned)s_[1 * TP] << 16); o.y = (unsigned)s_[2 * TP] | ((unsigned)s_[3 * TP] << 16);
        o.z = (unsigned)s_[4 * TP] | ((unsigned)s_[5 * TP] << 16); o.w = (unsigned)s_[6 * TP] | ((unsigned)s_[7 * TP] << 16);
        *(GAS v4u*)(WT + (size_t)(dn0 + n) * K + k0 + 8 * c) = o; }
    LDS_WAIT(); asm volatile("" ::: "memory");
}
__device__ __forceinline__ void rms_rows_bf16(const float* X, const float* g, bf16* XN, int gw, int NGW, int) {
    constexpr int NR = 4;
    const int lane = fresh_tid() & 63;
    f32x4 gv[4];
#pragma unroll
    for (int j = 0; j < 4; ++j) gv[j] = ((const f32x4*)g)[64 * j + lane];
    for (int m = gw; m < M; m += NR * NGW) {
        f32x4 v[NR][4]; float s[NR];
#pragma unroll
        for (int k = 0; k < NR; ++k) { const int mk = (m + k * NGW < M) ? m + k * NGW : m; const GAS f32x4* xr = (const GAS f32x4*)(X + (size_t)mk * D) + lane;
#pragma unroll
            for (int j = 0; j < 4; ++j) v[k][j] = xr[64 * j]; }
#pragma unroll
        for (int k = 0; k < NR; ++k) { float a = 0.f;
#pragma unroll
            for (int j = 0; j < 4; ++j) a += (v[k][j].x * v[k][j].x + v[k][j].y * v[k][j].y) + (v[k][j].z * v[k][j].z + v[k][j].w * v[k][j].w);
            s[k] = __builtin_amdgcn_rsqf(wave_sum(a) * (1.f / D) + RMS_EPS); }
#pragma unroll
        for (int k = 0; k < NR; ++k) if (m + k * NGW < M) { GAS unsigned long long* o8 = (GAS unsigned long long*)(XN + (size_t)(m + k * NGW) * D) + lane;
#pragma unroll
            for (int j = 0; j < 4; ++j) { const f32x4 y = v[k][j] * s[k] * gv[j]; o8[64 * j] = (unsigned long long)pk2(y.x, y.y) | ((unsigned long long)pk2(y.z, y.w) << 32); } }
    }
}
__device__ __forceinline__ void rms_rows_f32_inplace(float* X, const float* g, int gw, int NGW, int) {
    constexpr int NR = 4;
    const int lane = fresh_tid() & 63;
    f32x4 gv[4];
#pragma unroll
    for (int j = 0; j < 4; ++j) gv[j] = ((const f32x4*)g)[64 * j + lane];
    for (int m = gw; m < M; m += NR * NGW) {
        f32x4 v[NR][4]; float s[NR];
#pragma unroll
        for (int k = 0; k < NR; ++k) { const int mk = (m + k * NGW < M) ? m + k * NGW : m; const GAS f32x4* xr = (const GAS f32x4*)(X + (size_t)mk * D) + lane;
#pragma unroll
            for (int j = 0; j < 4; ++j) v[k][j] = xr[64 * j]; }
#pragma unroll
        for (int k = 0; k < NR; ++k) { float a = 0.f;
#pragma unroll
            for (int j = 0; j < 4; ++j) a += (v[k][j].x * v[k][j].x + v[k][j].y * v[k][j].y) + (v[k][j].z * v[k][j].z + v[k][j].w * v[k][j].w);
            s[k] = __builtin_amdgcn_rsqf(wave_sum(a) * (1.f / D) + RMS_EPS); }
#pragma unroll
        for (int k = 0; k < NR; ++k) if (m + k * NGW < M) { GAS f32x4* xr = (GAS f32x4*)(X + (size_t)(m + k * NGW) * D) + lane;
#pragma unroll
            for (int j = 0; j < 4; ++j) xr[64 * j] = v[k][j] * s[k] * gv[j]; }
    }
}
__device__ __forceinline__ float bfl(unsigned w) { return __uint_as_float(w << 16); }
__device__ __forceinline__ float bfh(unsigned w) { return __uint_as_float(w & 0xffff0000u); }
__device__ __forceinline__ void conv_pass(const bf16* Vb, const bf16* Gb, const float* cw  , bf16* Y, int gtid, int nthreads) {
    const int chunk = gtid & 127; const int r0 = gtid >> 7, rstep = nthreads >> 7;
    float w0[8], w1[8], w2[8];
#pragma unroll
    for (int e = 0; e < 8; ++e) { const float* p = cw + (size_t)(chunk * 8 + e) * 3; w0[e] = p[0]; w1[e] = p[1]; w2[e] = p[2]; }
    constexpr int NRC = 4;
    for (int row = r0; row < M; row += NRC * rstep) {
        v4u c2[NRC], c1[NRC], c0[NRC], gg[NRC]; size_t off[NRC];
#pragma unroll
        for (int k = 0; k < NRC; ++k) { const int rw = row + k * rstep; const int rr = rw < M ? rw : row; const int s = rr & (T - 1);
            off[k] = (size_t)rr * D + chunk * 8;
            c2[k] = *(const GAS v4u*)(Vb + off[k]); c1[k] = (v4u){0u, 0u, 0u, 0u}; c0[k] = (v4u){0u, 0u, 0u, 0u};
            if (s >= 1) c1[k] = *(const GAS v4u*)(Vb + off[k] - D);
            if (s >= 2) c0[k] = *(const GAS v4u*)(Vb + off[k] - 2 * D);
            gg[k] = *(const GAS v4u*)(Gb + off[k]); }
#pragma unroll
        for (int k = 0; k < NRC; ++k) { if (row + k * rstep < M) { v4u o;
#pragma unroll
            for (int q = 0; q < 4; ++q) {
                const float ylo = bfl(gg[k][q]) * (w0[2 * q] * bfl(c0[k][q]) + w1[2 * q] * bfl(c1[k][q]) + w2[2 * q] * bfl(c2[k][q]));
                const float yhi = bfh(gg[k][q]) * (w0[2 * q + 1] * bfh(c0[k][q]) + w1[2 * q + 1] * bfh(c1[k][q]) + w2[2 * q + 1] * bfh(c2[k][q]));
                o[q] = pk2(ylo, yhi);
            }
            *(GAS v4u*)(Y + off[k]) = o; } }
    }
}

typedef GAS unsigned gu32;
#define XB_TMO      128
#define XB_XCNT(j)  (256  + 64 * (j))
#define XB_XSUB(j)  (1280 + 64 * (j))
#define XB_XGEN(j)  (2304 + 64 * (j))
#define XB_TOP      3328
#define XB_TOPGEN   3392
#define XCD_BAR_WORDS 3456
#define XB_SPIN_CAP (1u << 18)

__device__ __forceinline__ unsigned xb_ld(unsigned* p)              { return __hip_atomic_load(p, __ATOMIC_RELAXED, __HIP_MEMORY_SCOPE_AGENT); }
__device__ __forceinline__ unsigned xb_add(unsigned* p, unsigned v) { return __hip_atomic_fetch_add(p, v, __ATOMIC_RELAXED, __HIP_MEMORY_SCOPE_AGENT); }
__device__ __forceinline__ unsigned xb_xcc_id() { return (unsigned)__builtin_amdgcn_s_getreg((3 << 11) | 20) & 0xFu; }
#define XB_SPIN(cond, bar) do { unsigned _sp = 0; while (cond) { __builtin_amdgcn_s_sleep(1); \
    if ((++_sp & 255u) == 0u) { if (xb_ld(&(bar)[XB_TMO])) break; if (_sp > XB_SPIN_CAP) { atomicAdd(&(bar)[XB_TMO], 1u); break; } } } } while (0)

struct XcdBarrier {
    unsigned* bar; unsigned x;
    volatile LAS unsigned* st;
};

__device__ __forceinline__ XcdBarrier xcd_barrier_post(unsigned* bar, volatile LAS unsigned* st) {
    XcdBarrier b; b.bar = bar; b.x = xb_xcc_id(); b.st = st;
    if (threadIdx.x == 0) (void)xb_add(&bar[XB_XCNT(b.x)], 1u);
    return b;
}
__device__ __forceinline__ void xcd_barrier_complete(unsigned* bar, unsigned x, unsigned& nloc, unsigned& nx) {
    const unsigned G = gridDim.x * gridDim.y * gridDim.z;
    unsigned sum, cnt, mine, sp = 0u;
    for (;;) {
        sum = 0u; cnt = 0u; mine = 0u;
#pragma unroll
        for (unsigned j = 0; j < 16; ++j) { const unsigned c = xb_ld(&bar[XB_XCNT(j)]); sum += c; cnt += (c > 0u) ? 1u : 0u; mine = (j == x) ? c : mine; }
        if (sum == G) break;
        __builtin_amdgcn_s_sleep(1);
        if ((++sp & 255u) == 0u) { if (xb_ld(&bar[XB_TMO])) break; if (sp > XB_SPIN_CAP) { atomicAdd(&bar[XB_TMO], 1u); break; } }
    }
    nloc = mine > 0u ? mine : 1u; nx = cnt > 0u ? cnt : 1u;
}

__device__ __forceinline__ void xcd_barrier(const XcdBarrier& b) {
    asm volatile("s_waitcnt vmcnt(0)" ::: "memory");
    __syncthreads();
    if (threadIdx.x == 0) {
        unsigned* bar = b.bar;
        __builtin_amdgcn_s_waitcnt(0);
        unsigned nloc = b.st[0], nx = b.st[1];
        if (nloc == 0u) { xcd_barrier_complete(bar, b.x, nloc, nx); b.st[0] = nloc; b.st[1] = nx; }
        const unsigned old = xb_add(&bar[XB_XSUB(b.x)], 1u);
        const unsigned gen = old / nloc;
        if (old + 1u == (gen + 1u) * nloc) {
            __builtin_amdgcn_fence(__ATOMIC_RELEASE, "agent");
            asm volatile("s_waitcnt vmcnt(0)" ::: "memory");
            const unsigned og = xb_add(&bar[XB_TOP], 1u);
            const unsigned tg = og / nx;
            if (og + 1u == (tg + 1u) * nx) xb_add(&bar[XB_TOPGEN], 1u);
            else XB_SPIN(xb_ld(&bar[XB_TOPGEN]) == tg, bar);
            __builtin_amdgcn_fence(__ATOMIC_ACQUIRE, "agent");
            xb_add(&bar[XB_XGEN(b.x)], 1u);
            asm volatile("s_waitcnt vmcnt(0)" ::: "memory");
        } else {
            XB_SPIN(xb_ld(&bar[XB_XGEN(b.x)]) == gen, bar);
            __builtin_amdgcn_fence(__ATOMIC_ACQUIRE, "agent");
            asm volatile("s_waitcnt vmcnt(0)" ::: "memory");
        }
    }
    __syncthreads();
}

struct Args { const float* in[12]; float* out; unsigned char* ws; };
__global__ void __launch_bounds__(NWAVES * 64, 2) trunk_fwd(Args args) {
    extern __shared__ __attribute__((aligned(16))) unsigned char lds[];
    cg::grid_group grid = cg::this_grid();
    const int tid = threadIdx.x, lane = tid & 63, wave = __builtin_amdgcn_readfirstlane(tid >> 6);
    const int G = gridDim.x, bx = blockIdx.x;
    const int vcu = (G % 8 == 0) ? (bx % 8) * (G / 8) + bx / 8 : bx;
    const int gw = vcu * NWAVES + wave, NGW = G * NWAVES;
    unsigned char* ws = args.ws;
    const float* x_in = args.in[0]; const float* norm_g = args.in[1]; const float* w_in = args.in[2]; const float* w_out = args.in[3]; const float* conv_w = args.in[4];
    const float* lq1 = args.in[5]; const float* lk1 = args.in[6]; const float* lq2 = args.in[7]; const float* lk2 = args.in[8];
    const float* subln_g = args.in[9]; const float* rel_bias = args.in[10]; const float* final_g = args.in[11];
    float* X = args.out;
    bf16* Win_t = (bf16*)(ws + WS_WIN); bf16* Wout_t = (bf16*)(ws + WS_WOUT); bf16* XN = (bf16*)(ws + WS_XN); bf16* Y = (bf16*)(ws + WS_Y); bf16* P = (bf16*)(ws + WS_P);
    LAS unsigned char* ldsl = (LAS unsigned char*)lds;
    volatile LAS unsigned* MISC = (volatile LAS unsigned*)(ldsl + RING_BYTES + 320);
    if (tid < 32) MISC[tid] = 0u;
    __syncthreads();
    const XcdBarrier bar = xcd_barrier_post((unsigned*)ws, MISC + 8);
#define GRID_BAR() xcd_barrier(bar)

    {
        LAS float* scr = (LAS float*)(ldsl + wave * 16384);
        constexpr int I_IN = (D / 64) * (NP / 64), I_OUT = (D / 64) * (D / 64);
        constexpr int NITEMS = DEPTH * (I_IN + I_OUT);
        for (int it = gw; it < NITEMS; it += NGW) {
            if (it < DEPTH * I_IN) { const int l = it / I_IN, r = it % I_IN; p0_transpose_item(w_in + (size_t)l * D * NP, D, NP, Win_t + (size_t)l * NP * D, (l & 1) == 0, scr, r, lane, nullptr); }
            else { const int it2 = it - DEPTH * I_IN; const int l = it2 / I_OUT, r = it2 % I_OUT; p0_transpose_item(w_out + (size_t)l * D * D, D, D, Wout_t + (size_t)l * D * D, 0, scr, r, lane, nullptr); }
        }
        rms_rows_bf16(x_in, norm_g, XN, gw, NGW, lane);
    }
    grid.sync();

    for (int l = 0; l < DEPTH; ++l) {
        const bool is_attn = (l & 1) != 0; const int j = l >> 1;
        if (l > 0) { rms_rows_bf16(X, norm_g + (size_t)l * D, XN, gw, NGW, lane); GRID_BAR(); }
        {
            pg8::Gemm g{XN, Win_t + (size_t)l * NP * D, M, NP, D}; pg8::StaticOrder S; S.init(M, NP, G, bx);
            if (is_attn) { pg8::EpiAttn E{P, (unsigned char*)P + 128 * MiB, attn_body::C2}; pg8::gemm_phase<pg8::EpiAttn, pg8::StaticOrder, true, true>(ldsl, g, S, E); }
            else { pg8::EpiConvGate E{P, P + (size_t)M * D}; pg8::gemm_phase<pg8::EpiConvGate, pg8::StaticOrder, true, true>(ldsl, g, S, E); }
        }
        GRID_BAR();
        if (is_attn) {
            const float linit = 0.8f - 0.6f * expf(-0.3f * (float)l);
            const float d1 = wave_sum(lq1[j * 64 + lane] * lk1[j * 64 + lane]), d2 = wave_sum(lq2[j * 64 + lane] * lk2[j * 64 + lane]);
            const float lam = expf(d1) - expf(d2) + linit;
            for (int rep = 0; rep < PROBE_ATTN_REP; ++rep) {
            attn_body::AttnArgs A{P, (const unsigned char*)P + 128 * MiB, rep == 0 ? Y : XN, rel_bias, subln_g + (size_t)j * 128, lam, 1.0f - linit};
            for (int v = vcu; v < 256; v += G) {
                const int s = v & 7, bh = v >> 3;
#pragma unroll 1
                for (int i = 0; i < 8; ++i) { const int qb = (i & 1) ? (16 * (i >> 1) + 15 - s) : (16 * (i >> 1) + s);
                    attn_body::attn_unit<8>(bh / attn_body::NHEAD, bh % attn_body::NHEAD, qb, A, (char*)lds, i == 0); }
            }
            }
        } else {
            conv_pass(P, P + (size_t)M * D, conv_w + (size_t)j * D * 3, Y, vcu * (NWAVES * 64) + fresh_tid(), G * NWAVES * 64);
        }
        GRID_BAR();
        {
            pg8::Gemm g{Y, Wout_t + (size_t)l * D * D, M, D, D}; pg8::StaticOrder S; S.init(M, D, G, bx);
            pg8::EpiRes E{l == 0 ? x_in : X, X, D};
            pg8::gemm_phase<pg8::EpiRes, pg8::StaticOrder, true, true>(ldsl, g, S, E);
        }
        GRID_BAR();
    }
    rms_rows_f32_inplace(X, final_g, gw, NGW, lane);
}

extern "C" void kernel_launch(void* const* d_in, const int* in_sizes, int n_in, void* d_out, int out_size, void* d_ws, size_t ws_size, hipStream_t stream) {
    static int grid = 0;
    if (grid == 0) {
        if (n_in != 12 || in_sizes[0] != M * D || out_size != M * D || ws_size < WS_END) { fprintf(stderr, "kernel_launch: unexpected shapes: n_in %d in0 %d out %d ws %zu (need %zu)\n", n_in, n_in > 0 ? in_sizes[0] : -1, out_size, ws_size, (size_t)WS_END); grid = -1; return; }
        int dev = 0, cus = 0, per_cu = 0;
        hipGetDevice(&dev); hipDeviceGetAttribute(&cus, hipDeviceAttributeMultiprocessorCount, dev);
        if (hipFuncSetAttribute((const void*)trunk_fwd, hipFuncAttributeMaxDynamicSharedMemorySize, LDS_BYTES) != hipSuccess) { fprintf(stderr, "kernel_launch: hipFuncSetAttribute failed\n"); grid = -1; return; }
        if (hipOccupancyMaxActiveBlocksPerMultiprocessor(&per_cu, (const void*)trunk_fwd, NWAVES * 64, LDS_BYTES) != hipSuccess || per_cu < 1) { fprintf(stderr, "kernel_launch: occupancy query gave %d\n", per_cu); per_cu = 1; }
        (void)hipGetLastError();
        grid = cus;
        fprintf(stderr, "kernel_launch: grid %d (cus %d, per_cu %d)\n", grid, cus, per_cu);
    }
    if (grid < 0) return;
    if (hipMemsetAsync(d_ws, 0, 65536, stream) != hipSuccess) { fprintf(stderr, "kernel_launch: memset failed\n"); return; }
    Args a{};
    for (int i = 0; i < 12; ++i) a.in[i] = (const float*)d_in[i];
    a.out = (float*)d_out; a.ws = (unsigned char*)d_ws;
    void* kargs[] = {&a};
    hipError_t e = hipLaunchCooperativeKernel((const void*)trunk_fwd, dim3(grid), dim3(NWAVES * 64), kargs, LDS_BYTES, stream);
    if (e != hipSuccess) fprintf(stderr, "kernel_launch: cooperative launch failed: %s (grid %d)\n", hipGetErrorString(e), grid);
}
```

```cpp
#include <hip/hip_runtime.h>
#include <hip/hip_cooperative_groups.h>
#include <hip/hip_bf16.h>
#include <cstdio>
#include <cstdint>
#include <cmath>
namespace cg = cooperative_groups;
template <int K> __device__ __forceinline__ float swz_xor(float v) { return __int_as_float(__builtin_amdgcn_ds_swizzle(__float_as_int(v), (K << 10) | 0x1f)); }
__device__ __forceinline__ float half_sum32(float v) { v += swz_xor<1>(v); v += swz_xor<2>(v); v += swz_xor<4>(v); v += swz_xor<8>(v); v += swz_xor<16>(v); return v; }
__device__ __forceinline__ float wave_sum64(float v) { v = half_sum32(v); auto rr = __builtin_amdgcn_permlane32_swap(__float_as_uint(v), __float_as_uint(v), false, false); return __uint_as_float(rr[0]) + __uint_as_float(rr[1]); }
__device__ __forceinline__ int fresh_tid() { int t = threadIdx.x; asm volatile("" : "+v"(t)); return t; }
namespace pg8 {
#define PG8_LAS __attribute__((address_space(3)))
typedef unsigned short bf16_t;
typedef short bf16x8 __attribute__((ext_vector_type(8)));
typedef float f32x4 __attribute__((ext_vector_type(4)));
typedef unsigned u32x4 __attribute__((ext_vector_type(4)));
constexpr int BM = 256, BK = 64, HALF = 128, HTB = HALF * BK * 2  , STAGE_BYTES = 8 * HTB, NXCD = 8, WGM = 8;

__host__ __device__ __forceinline__ int lds_byte(int r, int c) { const int st = (r >> 4) * 2 + (c >> 5), rr = r & 15, cc = c & 31, ob = rr * 64 + cc * 2; return st * 1024 + (ob ^ (((ob >> 9) & 1) << 5)); }
__host__ __device__ __forceinline__ void stage_rc(int b, int& R, int& C) { const int st = b / 1024, sb = b % 1024, swz = sb ^ (((sb >> 9) & 1) << 5); R = (st >> 1) * 16 + swz / 64; C = (st & 1) * 32 + (swz % 64) / 2; }
__host__ __device__ __forceinline__ int perm32(int rho) { const int n = rho >> 4, i = rho & 15; return 8 * (i >> 2) + 4 * n + (i & 3); }

struct Unit { int pm, pn; };
struct Gemm { const bf16_t* A; const bf16_t* Bt; int M, N, K; };

struct StaticOrder {
    int nM, nN, nwg, G, c;
    __host__ __device__ void init(int M, int N, int G_, int c_) { nM = M / BM; nN = N / BM; nwg = nM * nN; G = G_; c = c_; }
    __host__ __device__ bool next(int i, Unit& u) const {
        const long L = (long)i * G + c; if (L >= nwg) return false;
        int wgid = (int)L; { const int q = nwg / NXCD, r = nwg % NXCD, xcd = wgid % NXCD, off = wgid / NXCD; wgid = (xcd < r ? xcd * (q + 1) : r * (q + 1) + (xcd - r) * q) + off; }
        const int nig = WGM * nN, gid = wgid / nig, fm = gid * WGM, gsz = (nM - fm) < WGM ? (nM - fm) : WGM;
        u.pm = fm + ((wgid % nig) % gsz); u.pn = (wgid % nig) / gsz; return true;
    }
    __device__ __forceinline__ void a_ready(const Unit&) const {}
    __device__ __forceinline__ void done(const Unit&) const {}
};


__device__ __forceinline__ unsigned cvt_pk_bf16(float lo, float hi) { unsigned r; asm volatile("v_cvt_pk_bf16_f32 %0, %1, %2" : "=v"(r) : "v"(lo), "v"(hi)); return r; }
__device__ __forceinline__ float silu_f(float z) { return z * __builtin_amdgcn_rcpf(1.0f + __builtin_amdgcn_exp2f(-1.4426950408889634f * z)); }

struct EpiBf16 {
    static constexpr bool PERM = true, AFTER_DRAIN = false;
    bf16_t* O; int ldc; int scale_cols; float scale0;
    __device__ __forceinline__ void operator()(const f32x4 (&acc)[2][2][4][2], const Unit& u, int wr, int wc, int fr, int fq) const {
        const int row0 = u.pm * BM + wr * 64 + fr; const int colt = u.pn * BM;
        const float sc = (colt < scale_cols) ? scale0 : 1.f;
        const int col0 = colt + wc * 32 + 8 * fq;
#pragma unroll
        for (int ai = 0; ai < 2; ++ai)
#pragma unroll
            for (int m = 0; m < 4; ++m) { bf16_t* rowp = O + (size_t)(row0 + ai * HALF + m * 16) * ldc + col0;
#pragma unroll
                for (int bj = 0; bj < 2; ++bj) { f32x4 v0 = acc[ai][bj][m][0] * sc, v1 = acc[ai][bj][m][1] * sc;
                    u32x4 w; w.x = cvt_pk_bf16(v0[0], v0[1]); w.y = cvt_pk_bf16(v0[2], v0[3]); w.z = cvt_pk_bf16(v1[0], v1[1]); w.w = cvt_pk_bf16(v1[2], v1[3]);
                    *(u32x4*)(rowp + bj * HALF) = w; } }
    }
};
struct EpiAttn {
    static constexpr bool PERM = true, AFTER_DRAIN = false;
    bf16_t* QZ; unsigned char* KV; float scale0;
    __device__ __forceinline__ void operator()(const f32x4 (&acc)[2][2][4][2], const Unit& u, int wr, int wc, int fr, int fq) const {
        const int part = u.pn >> 2;
        if (part == 0 || part == 3) {
            const float sc = (part == 0) ? scale0 : 1.f;
            const int row0 = u.pm * BM + wr * 64 + fr; const int col0 = (part == 0 ? 0 : 1024) + (u.pn & 3) * BM + wc * 32 + 8 * fq;
#pragma unroll
            for (int ai = 0; ai < 2; ++ai)
#pragma unroll
                for (int m = 0; m < 4; ++m) { bf16_t* rowp = QZ + (size_t)(row0 + ai * HALF + m * 16) * 2048 + col0;
#pragma unroll
                    for (int bj = 0; bj < 2; ++bj) { f32x4 v0 = acc[ai][bj][m][0] * sc, v1 = acc[ai][bj][m][1] * sc;
                        u32x4 w; w.x = cvt_pk_bf16(v0[0], v0[1]); w.y = cvt_pk_bf16(v0[2], v0[3]); w.z = cvt_pk_bf16(v1[0], v1[1]); w.w = cvt_pk_bf16(v1[2], v1[3]);
                        *(u32x4*)(rowp + bj * HALF) = w; } }
        } else if (part == 1) {
            const int b = u.pm >> 5, t0 = (u.pm & 31) * 4 + wr;
            const int inner = (4 * wc + fq) * 1024 + fr * 16;
#pragma unroll
            for (int bj = 0; bj < 2; ++bj) { const int h = (u.pn & 3) * 2 + bj;
#pragma unroll
                for (int ai = 0; ai < 2; ++ai) { unsigned char* img = KV + ((size_t)((b * 8 + h) * 128 + t0 + 2 * ai) << 15) + inner;
#pragma unroll
                    for (int m = 0; m < 4; ++m) { const f32x4 v0 = acc[ai][bj][m][0], v1 = acc[ai][bj][m][1];
                        u32x4 w; w.x = cvt_pk_bf16(v0[0], v0[1]); w.y = cvt_pk_bf16(v0[2], v0[3]); w.z = cvt_pk_bf16(v1[0], v1[1]); w.w = cvt_pk_bf16(v1[2], v1[3]);
                        *(u32x4*)(img + m * 256) = w; } } }
        } else {
            const int b = u.pm >> 5, t0 = (u.pm & 31) * 4 + wr;
            const int inner = 16384 + wc * 4096 + ((fr >> 2) & 1) * 512 + (8 * fq) * 16 + ((fr & 3) + 4 * (fr >> 3)) * 2;
#pragma unroll
            for (int bj = 0; bj < 2; ++bj) { const int h = (u.pn & 3) * 2 + bj;
#pragma unroll
                for (int ai = 0; ai < 2; ++ai) { unsigned char* img = KV + ((size_t)((b * 8 + h) * 128 + t0 + 2 * ai) << 15) + inner;
#pragma unroll
                    for (int m = 0; m < 4; ++m) { const f32x4 v0 = acc[ai][bj][m][0], v1 = acc[ai][bj][m][1];
                        const unsigned w0 = cvt_pk_bf16(v0[0], v0[1]), w1 = cvt_pk_bf16(v0[2], v0[3]), w2 = cvt_pk_bf16(v1[0], v1[1]), w3 = cvt_pk_bf16(v1[2], v1[3]);
                        unsigned short* p = (unsigned short*)(img + m * 1024);
                        p[0 * 8] = (unsigned short)w0; p[1 * 8] = (unsigned short)(w0 >> 16); p[2 * 8] = (unsigned short)w1; p[3 * 8] = (unsigned short)(w1 >> 16);
                        p[4 * 8] = (unsigned short)w2; p[5 * 8] = (unsigned short)(w2 >> 16); p[6 * 8] = (unsigned short)w3; p[7 * 8] = (unsigned short)(w3 >> 16); } } }
        }
    }
};
struct EpiConvGate {
    static constexpr bool PERM = true, AFTER_DRAIN = false;
    bf16_t* Vb; bf16_t* Gb;
    __device__ __forceinline__ void operator()(const f32x4 (&acc)[2][2][4][2], const Unit& u, int wr, int wc, int fr, int fq) const {
        const int row0 = u.pm * BM + wr * 64 + fr;
        const bool isg = wc >= 2;
        bf16_t* base = (isg ? Gb : Vb) + u.pn * 64 + (wc & 1) * 32 + 8 * fq;
#pragma unroll
        for (int ai = 0; ai < 2; ++ai)
#pragma unroll
            for (int m = 0; m < 4; ++m) { bf16_t* rowp = base + (size_t)(row0 + ai * HALF + m * 16) * 1024;
                f32x4 a0 = acc[ai][0][m][0], a1 = acc[ai][0][m][1], b0 = acc[ai][1][m][0], b1 = acc[ai][1][m][1];
                if (isg) {
#pragma unroll
                    for (int e = 0; e < 4; ++e) { b0[e] = silu_f(b0[e]); b1[e] = silu_f(b1[e]); }
                }
                const f32x4 v0 = a0 * b0, v1 = a1 * b1;
                u32x4 w; w.x = cvt_pk_bf16(v0[0], v0[1]); w.y = cvt_pk_bf16(v0[2], v0[3]); w.z = cvt_pk_bf16(v1[0], v1[1]); w.w = cvt_pk_bf16(v1[2], v1[3]);
                *(u32x4*)rowp = w; }
    }
};
struct EpiRes {
    static constexpr bool PERM = false, AFTER_DRAIN = false;
    const float* base; float* out; int ldc;
    __device__ __forceinline__ void operator()(const f32x4 (&acc)[2][2][4][2], const Unit& u, int wr, int wc, int fr, int fq) const {
        const int col0 = u.pn * BM + wc * 32 + 4 * fq;
#pragma unroll
        for (int ai = 0; ai < 2; ++ai) {
            const size_t off0 = (size_t)(u.pm * BM + ai * HALF + wr * 64 + fr) * ldc + col0;
            f32x4 pre[4][2][2];
#pragma unroll
            for (int m = 0; m < 4; ++m)
#pragma unroll
                for (int bj = 0; bj < 2; ++bj)
#pragma unroll
                    for (int n = 0; n < 2; ++n) pre[m][bj][n] = *(const f32x4*)(base + off0 + (size_t)(m * 16) * ldc + bj * HALF + n * 16);
#pragma unroll
            for (int m = 0; m < 4; ++m)
#pragma unroll
                for (int bj = 0; bj < 2; ++bj)
#pragma unroll
                    for (int n = 0; n < 2; ++n) *(f32x4*)(out + off0 + (size_t)(m * 16) * ldc + bj * HALF + n * 16) = pre[m][bj][n] + acc[ai][bj][m][n];
            asm volatile("" ::: "memory");
        }
    }
};

template <class Epi, class Sched, bool ALIGN_EPI = false, bool SP2 = false>
__device__ __forceinline__ void gemm_phase(PG8_LAS unsigned char* lds, const Gemm g, const Sched& S, const Epi& E) {
    const int tid = fresh_tid(), wid = __builtin_amdgcn_readfirstlane(tid >> 6), lane = tid & 63, wr = wid >> 2, wc = wid & 3, fr = lane & 15, fq = lane >> 4;
    const int K = g.K, nt = K / BK;
    unsigned voffA[2], voffB[2];
#pragma unroll
    for (int i = 0; i < 2; ++i) { int R, C; stage_rc(tid * 16 + i * 8192, R, C); const int Rb = Epi::PERM ? ((R & ~31) + perm32(R & 31)) : R;
        voffA[i] = (unsigned)(R * K + C) * 2u; voffB[i] = (unsigned)(Rb * K + C) * 2u; }
    const size_t kstep = (size_t)(BK * 2);
    const size_t hstep = (size_t)HALF * K * 2;
    const size_t tstep = 2 * hstep;
    const unsigned ldsw = (unsigned)wid * 1024u;
    const int aoff = lds_byte(wr * 64 + fr, fq * 8), boff = lds_byte(wc * 32 + fr, fq * 8);
#define PG8_SA(b, h) (((b) * 2 + (h)) * HTB)
#define PG8_SB(b, h) ((4 + (b) * 2 + (h)) * HTB)
#define PG8_STAGE(bufoff, gbase, voff) do { _Pragma("unroll") for (int _i = 0; _i < 2; ++_i) \
        __builtin_amdgcn_global_load_lds((const unsigned*)((const char*)(gbase) + (voff)[_i]), (PG8_LAS unsigned*)(lds + (bufoff) + ldsw + _i * 8192), 16, 0, 0); } while (0)
#define PG8_LDA(dst, b, h) do { _Pragma("unroll") for (int m = 0; m < 4; ++m) _Pragma("unroll") for (int k = 0; k < 2; ++k) dst[m][k] = *(const PG8_LAS bf16x8*)(lds + PG8_SA(b, h) + aoff + m * 2048 + k * 1024); } while (0)
#define PG8_LDB(dst, b, h) do { _Pragma("unroll") for (int n = 0; n < 2; ++n) _Pragma("unroll") for (int k = 0; k < 2; ++k) dst[n][k] = *(const PG8_LAS bf16x8*)(lds + PG8_SB(b, h) + boff + n * 2048 + k * 1024); } while (0)
#define PG8_MMA(ai, bj, At, Bt) do { __builtin_amdgcn_s_setprio(1); _Pragma("unroll") for (int m = 0; m < 4; ++m) _Pragma("unroll") for (int n = 0; n < 2; ++n) _Pragma("unroll") for (int k = 0; k < 2; ++k) \
        acc[ai][bj][m][n] = __builtin_amdgcn_mfma_f32_16x16x32_bf16(Bt[n][k], At[m][k], acc[ai][bj][m][n], 0, 0, 0); __builtin_amdgcn_s_setprio(0); } while (0)
#define PG8_WAIT_V(n) asm volatile("s_waitcnt vmcnt(" #n ")" ::: "memory")
#define PG8_WAIT_L(n) asm volatile("s_waitcnt lgkmcnt(" #n ")" ::: "memory")
#define PG8_BAR __builtin_amdgcn_s_barrier()
#define PG8_SCHED __builtin_amdgcn_sched_barrier(0)
    Unit cur, nxt; int ui = 0;
    if (!S.next(0, cur)) return;
    f32x4 acc[2][2][4][2];
#pragma unroll
    for (int a = 0; a < 2; ++a)
#pragma unroll
        for (int b = 0; b < 2; ++b)
#pragma unroll
            for (int m = 0; m < 4; ++m)
#pragma unroll
                for (int n = 0; n < 2; ++n) acc[a][b][m][n] = (f32x4){0.f, 0.f, 0.f, 0.f};
    bf16x8 At[4][2], B0[2][2], B1[2][2];
    const char* cA = (const char*)g.A + (size_t)cur.pm * tstep; const char* cB = (const char*)g.Bt + (size_t)cur.pn * tstep;
    S.a_ready(cur);
    if constexpr (SP2) {
        PG8_STAGE(PG8_SB(0, 0), cB, voffB); PG8_STAGE(PG8_SB(0, 1), cB + hstep, voffB); PG8_STAGE(PG8_SA(0, 0), cA, voffA); PG8_STAGE(PG8_SA(0, 1), cA + hstep, voffA);
        if (wr == 1) PG8_BAR;
        PG8_WAIT_V(2); PG8_BAR;
        PG8_STAGE(PG8_SB(1, 0), cB + kstep, voffB); PG8_STAGE(PG8_SA(1, 0), cA + kstep, voffA); PG8_STAGE(PG8_SB(1, 1), cB + hstep + kstep, voffB);
        PG8_WAIT_V(6); PG8_BAR;
    } else {
        PG8_STAGE(PG8_SB(0, 0), cB, voffB); PG8_STAGE(PG8_SA(0, 0), cA, voffA); PG8_STAGE(PG8_SB(0, 1), cB + hstep, voffB); PG8_STAGE(PG8_SA(0, 1), cA + hstep, voffA);
        if (wr == 1) PG8_BAR;
        PG8_WAIT_V(4); PG8_BAR;
        PG8_STAGE(PG8_SB(1, 0), cB + kstep, voffB); PG8_STAGE(PG8_SA(1, 0), cA + kstep, voffA); PG8_STAGE(PG8_SB(1, 1), cB + hstep + kstep, voffB);
        PG8_WAIT_V(6); PG8_BAR;
    }
    for (;;) {
        const bool has_next = S.next(ui + 1, nxt);
        const char* nA = has_next ? (const char*)g.A + (size_t)nxt.pm * tstep : cA; const char* nB = has_next ? (const char*)g.Bt + (size_t)nxt.pn * tstep : cB;
        for (int t = 0; t < nt; t += 2) {
            const bool last = (t == nt - 2);
            const char* a1 = cA + (size_t)(t + 1) * kstep;
            const char* a2 = last ? nA : cA + (size_t)(t + 2) * kstep; const char* b2 = last ? nB : cB + (size_t)(t + 2) * kstep;
            const char* a3 = a2 + kstep; const char* b3 = b2 + kstep;
            if (last && has_next) S.a_ready(nxt);
            if constexpr (SP2) {
            PG8_LDB(B0, 0, 0); PG8_LDB(B1, 0, 1); PG8_SCHED; PG8_LDA(At, 0, 0); PG8_STAGE(PG8_SA(1, 1), a1 + hstep, voffA);
            PG8_WAIT_V(8); PG8_WAIT_L(0); PG8_BAR; PG8_MMA(0, 0, At, B0); PG8_MMA(0, 1, At, B1); PG8_BAR; PG8_SCHED;
            PG8_LDA(At, 0, 1); PG8_STAGE(PG8_SB(0, 0), b2, voffB); PG8_STAGE(PG8_SB(0, 1), b2 + hstep, voffB); PG8_STAGE(PG8_SA(0, 0), a2, voffA);
            PG8_WAIT_V(8); PG8_WAIT_L(0); PG8_BAR; PG8_MMA(1, 0, At, B0); PG8_MMA(1, 1, At, B1); PG8_BAR; PG8_SCHED;
            PG8_LDB(B0, 1, 0); PG8_LDB(B1, 1, 1); PG8_SCHED; PG8_LDA(At, 1, 0); PG8_STAGE(PG8_SA(0, 1), a2 + hstep, voffA);
            PG8_WAIT_V(8); PG8_WAIT_L(0); PG8_BAR; PG8_MMA(0, 0, At, B0); PG8_MMA(0, 1, At, B1); PG8_BAR; PG8_SCHED;
            PG8_LDA(At, 1, 1); PG8_STAGE(PG8_SB(1, 0), b3, voffB); PG8_STAGE(PG8_SB(1, 1), b3 + hstep, voffB); PG8_STAGE(PG8_SA(1, 0), a3, voffA);
            PG8_WAIT_V(8); PG8_WAIT_L(0); PG8_BAR; PG8_MMA(1, 0, At, B0); PG8_MMA(1, 1, At, B1); PG8_BAR; PG8_SCHED;
            } else {
            PG8_LDB(B0, 0, 0); PG8_SCHED; PG8_LDA(At, 0, 0); PG8_STAGE(PG8_SA(1, 1), a1 + hstep, voffA);
            PG8_WAIT_L(8); PG8_BAR; PG8_WAIT_L(0); PG8_MMA(0, 0, At, B0); PG8_BAR; PG8_SCHED;
            PG8_LDB(B1, 0, 1); PG8_STAGE(PG8_SB(0, 0), b2, voffB);
            PG8_BAR; PG8_WAIT_L(0); PG8_MMA(0, 1, At, B1); PG8_BAR;
            PG8_LDA(At, 0, 1); PG8_STAGE(PG8_SA(0, 0), a2, voffA);
            PG8_BAR; PG8_WAIT_L(0); PG8_MMA(1, 0, At, B0); PG8_BAR; PG8_SCHED;
            PG8_STAGE(PG8_SB(0, 1), b2 + hstep, voffB);
            PG8_WAIT_V(6); PG8_BAR; PG8_MMA(1, 1, At, B1); PG8_BAR;
            PG8_LDB(B0, 1, 0); PG8_SCHED; PG8_LDA(At, 1, 0); PG8_STAGE(PG8_SA(0, 1), a2 + hstep, voffA);
            PG8_WAIT_L(8); PG8_BAR; PG8_WAIT_L(0); PG8_MMA(0, 0, At, B0); PG8_BAR; PG8_SCHED;
            PG8_LDB(B1, 1, 1); PG8_STAGE(PG8_SB(1, 0), b3, voffB);
            PG8_BAR; PG8_WAIT_L(0); PG8_MMA(0, 1, At, B1); PG8_BAR;
            PG8_LDA(At, 1, 1); PG8_STAGE(PG8_SA(1, 0), a3, voffA);
            PG8_BAR; PG8_WAIT_L(0); PG8_MMA(1, 0, At, B0); PG8_BAR; PG8_SCHED;
            PG8_STAGE(PG8_SB(1, 1), b3 + hstep, voffB);
            PG8_WAIT_V(6); PG8_BAR; PG8_MMA(1, 1, At, B1); PG8_BAR;
            }
        }
        if constexpr (ALIGN_EPI) { if (wr == 0) PG8_BAR; }
        if constexpr (!Epi::AFTER_DRAIN) { E(acc, cur, wr, wc, fr, fq); S.done(cur); }
        if (!has_next) break;
#pragma unroll
        for (int a = 0; a < 2; ++a)
#pragma unroll
            for (int b = 0; b < 2; ++b)
#pragma unroll
                for (int m = 0; m < 4; ++m)
#pragma unroll
                    for (int n = 0; n < 2; ++n) acc[a][b][m][n] = (f32x4){0.f, 0.f, 0.f, 0.f};
        cur = nxt; cA = nA; cB = nB; ++ui;
        if constexpr (ALIGN_EPI) { if (wr == 1) PG8_BAR; }
    }
    PG8_WAIT_V(0);
    if constexpr (!ALIGN_EPI) { if (wr == 0) PG8_BAR; }
    PG8_BAR;
    if constexpr (Epi::AFTER_DRAIN) { E.fused(acc, cur, wr, wc, fr, fq, lds, wid, lane); S.done(cur); }
#undef PG8_SA
#undef PG8_SB
#undef PG8_STAGE
#undef PG8_LDA
#undef PG8_LDB
#undef PG8_MMA
#undef PG8_WAIT_V
#undef PG8_WAIT_L
#undef PG8_BAR
#undef PG8_SCHED
}
}

namespace attn_body {
using bf16x8=__attribute__((ext_vector_type(8)))short;
using s16x4=__attribute__((ext_vector_type(4)))short;
using f32x16=__attribute__((ext_vector_type(16)))float;
using u32x4=__attribute__((ext_vector_type(4)))unsigned;
using f32x4g=__attribute__((ext_vector_type(4)))float;
typedef unsigned short bf16raw;
constexpr int SEQ=8192,PITCH=2048,YP=1024,NHEAD=8;
constexpr int NW=8,QBLK=32,QB=128,KVBLK=64,NQB=SEQ/QB;
constexpr int SLOT16=16384;
constexpr int LDS_KR=0,LDS_VR=3*SLOT16;
constexpr int LDS_WS=6*SLOT16, LDS_BIAS=LDS_WS+NW*64*4, LDS_DUMMY=LDS_BIAS+2048, LDS_BYTES=LDS_DUMMY+16384;
constexpr float LOG2E=1.4426950408889634f;
constexpr float C2=0.125f*LOG2E;
__device__ __forceinline__ int crow(int r,int hi){return (r&3)+8*(r>>2)+4*hi;}
#define SBAR() __builtin_amdgcn_sched_barrier(0)
__device__ __forceinline__ void glds16(const void*gsrc,unsigned lds_dst){unsigned keep;
  asm volatile("s_mov_b32 %0, m0\n\ts_mov_b32 m0, %2\n\ts_nop 0\n\tglobal_load_lds_dwordx4 %1, off\n\ts_mov_b32 m0, %0":"=&s"(keep):"v"(gsrc),"s"(lds_dst):"memory");}
__device__ __forceinline__ void glds16s(const void*sbase,unsigned voff,unsigned lds_dst){unsigned keep;
  asm volatile("s_mov_b32 %0, m0\n\ts_mov_b32 m0, %3\n\ts_nop 0\n\tglobal_load_lds_dwordx4 %2, %1\n\ts_mov_b32 m0, %0":"=&s"(keep):"s"(sbase),"v"(voff),"s"(lds_dst):"memory");}
typedef float f32x2_t __attribute__((ext_vector_type(2))); typedef __bf16 bf16x2_t __attribute__((ext_vector_type(2)));
__device__ __forceinline__ unsigned cvtpk_s(float lo,float hi){f32x2_t v={lo,hi};bf16x2_t b=__builtin_convertvector(v,bf16x2_t);return __builtin_bit_cast(unsigned,b);}
__device__ __forceinline__ float bf2f(bf16raw v){return __uint_as_float(((unsigned)v)<<16);}
#define WAIT_BAR(N) asm volatile("s_waitcnt vmcnt(" #N ") lgkmcnt(0)\n\ts_barrier":::"memory")
typedef __attribute__((address_space(3))) const char* lds_cptr;
typedef short v4i16_t __attribute__((ext_vector_type(4)));
__device__ __forceinline__ s16x4 vtr(lds_cptr p){ return __builtin_bit_cast(s16x4,__builtin_amdgcn_ds_read_tr16_b64_v4i16((__attribute__((address_space(3))) v4i16_t*)p)); }
__device__ __forceinline__ int t5_bucket(int d){ if(d<16)return d; int b=16+(int)(__builtin_log2f((float)d*(1.0f/16.0f))*(16.0f/3.0f)); return b>31?31:b; }

__device__ __forceinline__ void qkt(f32x16&p0,f32x16&p1,lds_cptr kb,const bf16x8*qr){
  const f32x16 z=f32x16{};
  #pragma unroll
  for(int d0=0;d0<4;++d0){
    const bf16x8 b0=*(const __attribute__((address_space(3))) bf16x8*)(kb+d0*2048);
    const bf16x8 b1=*(const __attribute__((address_space(3))) bf16x8*)(kb+d0*2048+512);
    if(d0==0){p0=__builtin_amdgcn_mfma_f32_32x32x16_bf16(b0,qr[0],z,0,0,0);p1=__builtin_amdgcn_mfma_f32_32x32x16_bf16(b1,qr[0],z,0,0,0);}
    else{p0=__builtin_amdgcn_mfma_f32_32x32x16_bf16(b0,qr[d0],p0,0,0,0);p1=__builtin_amdgcn_mfma_f32_32x32x16_bf16(b1,qr[d0],p1,0,0,0);}}
}
__device__ __forceinline__ float rowmax(const f32x16&p0,const f32x16&p1){
  float a=p0[0];
  #pragma unroll
  for(int r=1;r<16;++r)a=__builtin_fmaxf(a,p0[r]);
  float c=p1[0];
  #pragma unroll
  for(int r=1;r<16;++r)c=__builtin_fmaxf(c,p1[r]);
  a=__builtin_fmaxf(a,c);
  auto rr=__builtin_amdgcn_permlane32_swap(__float_as_uint(a),__float_as_uint(a),false,false);
  return __builtin_fmaxf(__uint_as_float(rr[0]),__uint_as_float(rr[1]));
}

struct AttnArgs { const bf16raw* P; const unsigned char* KV; bf16raw* Y; const float* relb; const float* subg; float lam; float onem; };

template<int THRL> __device__ __forceinline__ void attn_unit(int b,int h,int qb,const AttnArgs&A,char*shm,bool setup){
  const int tid=fresh_tid(),lane=tid&63,r32=lane&31,hi=lane>>5; const int wid=__builtin_amdgcn_readfirstlane(tid>>6);
  const int rg=wid&3,mp=wid>>2;
  const long rowbase=(long)b*SEQ; const int q0=qb*QB; const int qw0=q0+rg*QBLK;
  const bf16raw*Qw=A.P+(rowbase+qw0)*PITCH+(2*h+mp)*64;
  const unsigned char*imgS=A.KV+((size_t)((b*NHEAD+h)*(SEQ/KVBLK))<<15);
  const unsigned voff=(unsigned)(wid*1024+lane*16);
  const unsigned lds0=(unsigned)(uintptr_t)shm;
  float*wsf=(float*)(shm+LDS_WS)+wid*64;
  float*biasT=(float*)(shm+LDS_BIAS);
  float*xch=(float*)shm+rg*4096+lane;
  const lds_cptr shm3=(lds_cptr)shm;
  float*subgT=biasT+256;
  if(setup){
    if(tid<256){ const int m_=tid>>7,d=tid&127; biasT[tid]=A.relb[t5_bucket(d)*16+2*h+m_]*LOG2E; }
    else if(tid<384){ subgT[tid-256]=A.subg[tid-256]*A.onem; }
    asm volatile("s_waitcnt vmcnt(0) lgkmcnt(0)\n\ts_barrier":::"memory");
  }
  const float cfar=biasT[mp*128+127];
  const unsigned kdst=lds0+LDS_KR+wid*1024, vdst=lds0+LDS_VR+wid*1024, ddst=lds0+LDS_DUMMY+wid*1024;
  #define DMA_K(t,slot) do{ const unsigned char*g_=imgS+((size_t)(t)<<15); \
      glds16s(g_,voff,(unsigned)__builtin_amdgcn_readfirstlane(kdst+(slot))); glds16s(g_+8192,voff,(unsigned)__builtin_amdgcn_readfirstlane(kdst+(slot)+8192)); }while(0)
  #define DMA_V(t,slot) do{ const unsigned char*g_=imgS+((size_t)(t)<<15)+16384; \
      glds16s(g_,voff,(unsigned)__builtin_amdgcn_readfirstlane(vdst+(slot))); glds16s(g_+8192,voff,(unsigned)__builtin_amdgcn_readfirstlane(vdst+(slot)+8192)); }while(0)
  const lds_cptr kp0=shm3+LDS_KR+mp*8192+hi*1024+r32*16;
  const lds_cptr vp0=shm3+LDS_VR+hi*512+r32*16;
  const int NT=(q0+QB)/KVBLK;
  bf16x8 qr[4];
  #pragma unroll
  for(int d0=0;d0<4;++d0)qr[d0]=*reinterpret_cast<const bf16x8*>(&Qw[(long)r32*PITCH+d0*16+hi*8]);
  DMA_K(0,0); DMA_V(0,0); DMA_K(1,SLOT16);
  DMA_V(1,SLOT16); { const unsigned char*g_=imgS+((size_t)(NT>2?2:NT-1)<<15); const unsigned d_=(unsigned)__builtin_amdgcn_readfirstlane(NT>2?kdst+2*SLOT16:ddst); glds16s(g_,voff,d_); glds16s(g_+8192,voff,d_+8192); }
  float mhat=0.f,l=0.f;
  f32x16 o[4];
  #pragma unroll
  for(int d0=0;d0<4;++d0)o[d0]=f32x16{};
  const int qpos=qw0+r32;
  f32x16 p0,p1; u32x4 pw[4]; bf16x8 kf[8]; bf16x8 va[4],vb[4];
  f32x16 cini;
  #pragma unroll
  for(int r=0;r<16;++r)cini[r]=cfar;
  asm volatile("":"+v"(cini));
  #define LDK(kp_,o_) (*(const __attribute__((address_space(3))) bf16x8*)((kp_)+(o_)))
  #define KRD(kp_) do{ _Pragma("unroll") for(int d0_=0;d0_<4;++d0_){ kf[2*d0_]=LDK(kp_,d0_*2048); kf[2*d0_+1]=LDK(kp_,d0_*2048+512); } }while(0)
  #define QKM(z_) do{ \
      p0=__builtin_amdgcn_mfma_f32_32x32x16_bf16(kf[0],qr[0],z_,0,0,0); \
      _Pragma("unroll") for(int d0_=1;d0_<4;++d0_){ p0=__builtin_amdgcn_mfma_f32_32x32x16_bf16(kf[2*d0_],qr[d0_],p0,0,0,0); } \
      p1=__builtin_amdgcn_mfma_f32_32x32x16_bf16(kf[1],qr[0],z_,0,0,0); \
      _Pragma("unroll") for(int d0_=1;d0_<4;++d0_){ p1=__builtin_amdgcn_mfma_f32_32x32x16_bf16(kf[2*d0_+1],qr[d0_],p1,0,0,0); } }while(0)
  #define VRK(dst,vp_,ks_) do{ _Pragma("unroll") for(int d0_=0;d0_<4;++d0_){ dst[d0_]=*(const __attribute__((address_space(3))) bf16x8*)((vp_)+d0_*4096+(ks_)*1024); } }while(0)
  #define VFR(src,ks_) (bf16x8){src[2*(ks_)][0],src[2*(ks_)][1],src[2*(ks_)][2],src[2*(ks_)][3],src[2*(ks_)+1][0],src[2*(ks_)+1][1],src[2*(ks_)+1][2],src[2*(ks_)+1][3]}
  #define PVM(d0_,src) do{ _Pragma("unroll") for(int ks_=0;ks_<4;++ks_) o[d0_]=__builtin_amdgcn_mfma_f32_32x32x16_bf16(__builtin_bit_cast(bf16x8,pw[ks_]),VFR(src,ks_),o[d0_],0,0,0); }while(0)
  WAIT_BAR(8);
  KRD(kp0);
  int ks_t=0,ks_n=SLOT16,vs_t=0,vs_nn=2*SLOT16;
  for(int t=0;t<NT;++t){
    WAIT_BAR(4);
    const int kv0=t*KVBLK;
    const bool act=(kv0<=qw0+QBLK-1);
    const bool actn=(t+1<NT)&&(kv0+KVBLK<=qw0+QBLK-1);
    const lds_cptr vp=vp0+vs_t;
    const bool dk=(t+3<NT), dv=(t+2<NT);
    const unsigned char*gk_=imgS+((size_t)(dk?t+3:NT-1)<<15); const unsigned char*gv_=imgS+((size_t)(dv?t+2:NT-1)<<15)+16384;
    const unsigned kd_=(unsigned)__builtin_amdgcn_readfirstlane(dk?kdst+ks_t:ddst), vd_=(unsigned)__builtin_amdgcn_readfirstlane(dv?vdst+vs_nn:ddst);
    if(act){
      VRK(va,vp,0); VRK(vb,vp,1);
      SBAR();
      QKM(cini);
    }
    if(act){
      const bool far=(qw0-(kv0+63)>=113);
      if(!far){ const float*bt=biasT+mp*128; const int dq=qpos-kv0-4*hi;
        #pragma unroll
        for(int r=0;r<16;++r){ const int d=dq-((r&3)+8*(r>>2));
          const int i0=d<0?0:(d>127?127:d);
          const float b0=bt[i0];
          const float n0=d>=0?0.f:-INFINITY;
          p0[r]=(p0[r]+(b0-cfar))+n0; if((r&7)==7)asm volatile("":::"memory"); }
        #pragma unroll
        for(int r=0;r<16;++r){ const int d1=dq-32-((r&3)+8*(r>>2));
          const int i1=d1<0?0:(d1>127?127:d1);
          const float b1=bt[i1];
          const float n1=d1>=0?0.f:-INFINITY;
          p1[r]=(p1[r]+(b1-cfar))+n1; if((r&7)==7)asm volatile("":::"memory"); } }
      const float rm=rowmax(p0,p1);
      if(t==0||__any(rm>(float)THRL)){
        const float dl=(t==0)?rm:__builtin_fmaxf(rm,0.f);
        #pragma unroll
        for(int r=0;r<16;++r){p0[r]-=dl;p1[r]-=dl;}
        if(t>0){ const float f=__builtin_amdgcn_exp2f(-dl);
          l*=f;
          #pragma unroll
          for(int d0=0;d0<4;++d0)
            #pragma unroll
            for(int r=0;r<16;++r)o[d0][r]*=f; }
        mhat+=dl;
        { const float ci=cfar-mhat;
          #pragma unroll
          for(int r=0;r<16;++r)cini[r]=ci;
          asm volatile("":"+v"(cini)); }
      }
      #define EX2(P,B) do{ P[B]=__builtin_amdgcn_exp2f(P[B]); P[B+1]=__builtin_amdgcn_exp2f(P[B+1]); sacc+=P[B]; sacc+=P[B+1]; }while(0)
      #define QTR(P,B,W,I) do{ EX2(P,B); asm volatile("":"+v"(sacc)); { unsigned w_=cvtpk_s(P[B],P[B+1]); asm volatile("":"+v"(w_)); W[I]=w_; } }while(0)
      #define PV1(d0_,ks_,src) o[d0_]=__builtin_amdgcn_mfma_f32_32x32x16_bf16(src[d0_],__builtin_bit_cast(bf16x8,pw[ks_]),o[d0_],0,0,0)
      float sacc=0.f;
      QTR(p0,0,pw[0],0); QTR(p0,2,pw[0],1); QTR(p0,4,pw[0],2); QTR(p0,6,pw[0],3);
      SBAR();
      PV1(0,0,va); QTR(p0,8,pw[1],0);  SBAR();
      PV1(1,0,va); QTR(p0,10,pw[1],1); SBAR();
      PV1(2,0,va); QTR(p0,12,pw[1],2); SBAR();
      PV1(3,0,va); QTR(p0,14,pw[1],3); SBAR();
      VRK(va,vp,2); SBAR();
      PV1(0,1,vb); QTR(p1,0,pw[2],0);  SBAR();
      PV1(1,1,vb); QTR(p1,2,pw[2],1);  SBAR();
      PV1(2,1,vb); QTR(p1,4,pw[2],2);  SBAR();
      PV1(3,1,vb); QTR(p1,6,pw[2],3);  SBAR();
      VRK(vb,vp,3); SBAR();
      PV1(0,2,va); QTR(p1,8,pw[3],0);  SBAR();
      PV1(1,2,va); QTR(p1,10,pw[3],1); SBAR();
      PV1(2,2,va); QTR(p1,12,pw[3],2); SBAR();
      PV1(3,2,va); QTR(p1,14,pw[3],3); SBAR();
      KRD(kp0+ks_n); SBAR();
      PV1(0,3,vb); PV1(1,3,vb); PV1(2,3,vb); PV1(3,3,vb);
      l+=sacc;
      SBAR();
      #undef EX2
      #undef QTR
      #undef PV1
    }
    glds16s(gk_,voff,kd_); glds16s(gk_+8192,voff,kd_+8192); glds16s(gv_,voff,vd_); glds16s(gv_+8192,voff,vd_+8192);
    ks_t=ks_n; ks_n=(ks_n==2*SLOT16)?0:ks_n+SLOT16; vs_t=(vs_t==2*SLOT16)?0:vs_t+SLOT16; vs_nn=(vs_nn==2*SLOT16)?0:vs_nn+SLOT16;
  }
  #undef LDK
  #undef KRD
  #undef QKM
  #undef VRD
  #undef VRK
  #undef VFR
  #undef PVM
  {auto rr=__builtin_amdgcn_permlane32_swap(__float_as_uint(l),__float_as_uint(l),false,false);l=__uint_as_float(rr[0])+__uint_as_float(rr[1]);}
  const float ascl=(mp?A.lam:1.0f)/l;
  typedef unsigned u32x2e __attribute__((ext_vector_type(2)));
  u32x2e zq[4][4];
  const long orow=rowbase+qw0+r32;
  if(mp==0){
    const bf16raw*zp=A.P+orow*PITCH+1024+h*128+4*hi;
    #pragma unroll
    for(int d0=0;d0<4;++d0)
      #pragma unroll
      for(int g=0;g<4;++g)zq[d0][g]=*(const u32x2e*)(zp+d0*32+8*g);
  }
  asm volatile("s_waitcnt lgkmcnt(0)\n\ts_barrier":::"memory");
  if(mp==1){
    #pragma unroll
    for(int r=0;r<16;++r)
      #pragma unroll
      for(int d0=0;d0<4;++d0)xch[(d0*16+r)*64]=o[d0][r]*ascl;
  }
  asm volatile("s_waitcnt lgkmcnt(0)\n\ts_barrier":::"memory");
  if(mp==0){
    float ss=0.f;
    #pragma unroll
    for(int r=0;r<16;++r)
      #pragma unroll
      for(int d0=0;d0<4;++d0){ const float v_=o[d0][r]*ascl-xch[(d0*16+r)*64]; o[d0][r]=v_; ss+=v_*v_; }
    {auto rr=__builtin_amdgcn_permlane32_swap(__float_as_uint(ss),__float_as_uint(ss),false,false);ss=__uint_as_float(rr[0])+__uint_as_float(rr[1]);}
    const float rstd=__builtin_amdgcn_rsqf(ss*(1.0f/128.0f)+1e-6f);
    bf16raw*yp=A.Y+orow*YP+h*128+4*hi;
    #pragma unroll
    for(int d0=0;d0<4;++d0)
      #pragma unroll
      for(int g=0;g<4;++g){
        const f32x4g gs=*(const f32x4g*)(subgT+d0*32+8*g+4*hi);
        float y[4];
        #pragma unroll
        for(int e=0;e<4;++e){ const unsigned zw=(e<2)?zq[d0][g][0]:zq[d0][g][1]; const float z=__uint_as_float((e&1)?(zw&0xffff0000u):(zw<<16));
          const float sg=z*__builtin_amdgcn_rcpf(1.0f+__builtin_amdgcn_exp2f(-LOG2E*z)); y[e]=o[d0][4*g+e]*rstd*gs[e]*sg; }
        u32x2e w; w[0]=cvtpk_s(y[0],y[1]); w[1]=cvtpk_s(y[2],y[3]);
        *(u32x2e*)(yp+d0*32+8*g)=w; }
  }
  WAIT_BAR(0);
  #undef DMA_K
  #undef DMA_V
}
#undef WAIT_BAR
#undef SBAR
}

constexpr int NWAVES = 8;
constexpr int PROBE_ATTN_REP = 1;
constexpr int BATCH = 4, T = 8192, D = 1024, DEPTH = 4, NP = 4 * D;
constexpr int M = BATCH * T;
constexpr float RMS_EPS = 1e-6f;
constexpr size_t MiB = 1u << 20;
constexpr size_t WS_WIN = 2 * MiB;
constexpr size_t WS_WOUT = 34 * MiB;
constexpr size_t WS_XN = 48 * MiB;
constexpr size_t WS_Y = 112 * MiB;
constexpr size_t WS_P = 176 * MiB;
constexpr size_t WS_END = 432 * MiB;
constexpr int RING_BYTES = 131072;
constexpr int LDS_BYTES = 147456;
static_assert(attn_body::LDS_BYTES <= RING_BYTES, "attention LDS");

#define GAS __attribute__((address_space(1)))
#define LAS __attribute__((address_space(3)))
typedef unsigned short bf16;
typedef unsigned v4u __attribute__((ext_vector_type(4)));
typedef float f32x4 __attribute__((ext_vector_type(4)));
#define LDS_WAIT() asm volatile("s_waitcnt lgkmcnt(0)" ::: "memory")
__device__ __forceinline__ unsigned f2bf(float f) { unsigned u = __builtin_bit_cast(unsigned, f); return (u + 0x7fffu + ((u >> 16) & 1u)) >> 16; }
__device__ __forceinline__ unsigned pk2(float lo, float hi) { return f2bf(lo) | (f2bf(hi) << 16); }
__device__ __forceinline__ float wave_sum(float v) { return wave_sum64(v); }
__device__ __forceinline__ void p0_transpose_item(const float* W, int K, int N, bf16* WT, int conv, LAS float* scrf, int item, int lane, const float* gk) {
    LAS unsigned short* scr = (LAS unsigned short*)scrf;
    constexpr int TP = 68;
    const int nblk = N / 64, kb = item / nblk, nb = item % nblk, k0 = 64 * kb, n0 = 64 * nb;
    const int lr = lane >> 4, lc = (lane & 15) * 4;
    f32x4 v[16];
#pragma unroll
    for (int i = 0; i < 16; ++i) v[i] = *(const GAS f32x4*)(W + (size_t)(k0 + 4 * i + lr) * N + n0 + lc);
#pragma unroll
    for (int i = 0; i < 16; ++i) { const float g_ = gk ? gk[k0 + 4 * i + lr] : 1.0f; const f32x4 y = v[i] * g_;
        *(LAS unsigned long long*)(scr + (4 * i + lr) * TP + lc) = (unsigned long long)pk2(y.x, y.y) | ((unsigned long long)pk2(y.z, y.w) << 32); }
    LDS_WAIT(); asm volatile("" ::: "memory");
    int dn0 = n0;
    if (conv) { const int part = n0 >> 10, ch = n0 & 1023, pn = ch >> 6; const int slot = (part == 0) ? 1 : (part == 1) ? 0 : part; dn0 = 256 * pn + 64 * slot; }
    const int c = lane & 7;
#pragma unroll
    for (int j = 0; j < 8; ++j) { const int n = (lane >> 3) + 8 * j; const LAS unsigned short* s_ = scr + (8 * c) * TP + n;
        v4u o; o.x = (unsigned)s_[0 * TP] | ((unsigned)s_[1 * TP] << 16); o.y = (unsigned)s_[2 * TP] | ((unsigned)s_[3 * TP] << 16);
        o.z = (unsigned)s_[4 * TP] | ((unsigned)s_[5 * TP] << 16); o.w = (unsigned)s_[6 * TP] | ((unsigned)s_[7 * TP] << 16);
        *(GAS v4u*)(WT + (size_t)(dn0 + n) * K + k0 + 8 * c) = o; }
    LDS_WAIT(); asm volatile("" ::: "memory");
}
__device__ __forceinline__ void rms_rows_bf16(const float* X, const float* g, bf16* XN, int gw, int NGW, int) {
    constexpr int NR = 4;
    const int lane = fresh_tid() & 63;
    f32x4 gv[4];
#pragma unroll
    for (int j = 0; j < 4; ++j) gv[j] = ((const f32x4*)g)[64 * j + lane];
    for (int m = gw; m < M; m += NR * NGW) {
        f32x4 v[NR][4]; float s[NR];
#pragma unroll
        for (int k = 0; k < NR; ++k) { const int mk = (m + k * NGW < M) ? m + k * NGW : m; const GAS f32x4* xr = (const GAS f32x4*)(X + (size_t)mk * D) + lane;
#pragma unroll
            for (int j = 0; j < 4; ++j) v[k][j] = xr[64 * j]; }
#pragma unroll
        for (int k = 0; k < NR; ++k) { float a = 0.f;
#pragma unroll
            for (int j = 0; j < 4; ++j) a += (v[k][j].x * v[k][j].x + v[k][j].y * v[k][j].y) + (v[k][j].z * v[k][j].z + v[k][j].w * v[k][j].w);
            s[k] = __builtin_amdgcn_rsqf(wave_sum(a) * (1.f / D) + RMS_EPS); }
#pragma unroll
        for (int k = 0; k < NR; ++k) if (m + k * NGW < M) { GAS unsigned long long* o8 = (GAS unsigned long long*)(XN + (size_t)(m + k * NGW) * D) + lane;
#pragma unroll
            for (int j = 0; j < 4; ++j) { const f32x4 y = v[k][j] * s[k] * gv[j]; o8[64 * j] = (unsigned long long)pk2(y.x, y.y) | ((unsigned long long)pk2(y.z, y.w) << 32); } }
    }
}
__device__ __forceinline__ void rms_rows_f32_inplace(float* X, const float* g, int gw, int NGW, int) {
    constexpr int NR = 4;
    const int lane = fresh_tid() & 63;
    f32x4 gv[4];
#pragma unroll
    for (int j = 0; j < 4; ++j) gv[j] = ((const f32x4*)g)[64 * j + lane];
    for (int m = gw; m < M; m += NR * NGW) {
        f32x4 v[NR][4]; float s[NR];
#pragma unroll
        for (int k = 0; k < NR; ++k) { const int mk = (m + k * NGW < M) ? m + k * NGW : m; const GAS f32x4* xr = (const GAS f32x4*)(X + (size_t)mk * D) + lane;
#pragma unroll
            for (int j = 0; j < 4; ++j) v[k][j] = xr[64 * j]; }
#pragma unroll
        for (int k = 0; k < NR; ++k) { float a = 0.f;
#pragma unroll
            for (int j = 0; j < 4; ++j) a += (v[k][j].x * v[k][j].x + v[k][j].y * v[k][j].y) + (v[k][j].z * v[k][j].z + v[k][j].w * v[k][j].w);
            s[k] = __builtin_amdgcn_rsqf(wave_sum(a) * (1.f / D) + RMS_EPS); }
#pragma unroll
        for (int k = 0; k < NR; ++k) if (m + k * NGW < M) { GAS f32x4* xr = (GAS f32x4*)(X + (size_t)(m + k * NGW) * D) + lane;
#pragma unroll
            for (int j = 0; j < 4; ++j) xr[64 * j] = v[k][j] * s[k] * gv[j]; }
    }
}
__device__ __forceinline__ float bfl(unsigned w) { return __uint_as_float(w << 16); }
__device__ __forceinline__ float bfh(unsigned w) { return __uint_as_float(w & 0xffff0000u); }
__device__ __forceinline__ void conv_pass(const bf16* Vb, const bf16* Gb, const float* cw  , bf16* Y, int gtid, int nthreads) {
    const int chunk = gtid & 127; const int r0 = gtid >> 7, rstep = nthreads >> 7;
    float w0[8], w1[8], w2[8];
#pragma unroll
    for (int e = 0; e < 8; ++e) { const float* p = cw + (size_t)(chunk * 8 + e) * 3; w0[e] = p[0]; w1[e] = p[1]; w2[e] = p[2]; }
    constexpr int NRC = 4;
    for (int row = r0; row < M; row += NRC * rstep) {
        v4u c2[NRC], c1[NRC], c0[NRC], gg[NRC]; size_t off[NRC];
#pragma unroll
        for (int k = 0; k < NRC; ++k) { const int rw = row + k * rstep; const int rr = rw < M ? rw : row; const int s = rr & (T - 1);
            off[k] = (size_t)rr * D + chunk * 8;
            c2[k] = *(const GAS v4u*)(Vb + off[k]); c1[k] = (v4u){0u, 0u, 0u, 0u}; c0[k] = (v4u){0u, 0u, 0u, 0u};
            if (s >= 1) c1[k] = *(const GAS v4u*)(Vb + off[k] - D);
            if (s >= 2) c0[k] = *(const GAS v4u*)(Vb + off[k] - 2 * D);
            gg[k] = *(const GAS v4u*)(Gb + off[k]); }
#pragma unroll
        for (int k = 0; k < NRC; ++k) { if (row + k * rstep < M) { v4u o;
#pragma unroll
            for (int q = 0; q < 4; ++q) {
                const float ylo = bfl(gg[k][q]) * (w0[2 * q] * bfl(c0[k][q]) + w1[2 * q] * bfl(c1[k][q]) + w2[2 * q] * bfl(c2[k][q]));
                const float yhi = bfh(gg[k][q]) * (w0[2 * q + 1] * bfh(c0[k][q]) + w1[2 * q + 1] * bfh(c1[k][q]) + w2[2 * q + 1] * bfh(c2[k][q]));
                o[q] = pk2(ylo, yhi);
            }
            *(GAS v4u*)(Y + off[k]) = o; } }
    }
}

typedef GAS unsigned gu32;
#define XB_TMO      128
#define XB_XCNT(j)  (256  + 64 * (j))
#define XB_XSUB(j)  (1280 + 64 * (j))
#define XB_XGEN(j)  (2304 + 64 * (j))
#define XB_TOP      3328
#define XB_TOPGEN   3392
#define XCD_BAR_WORDS 3456
#define XB_SPIN_CAP (1u << 18)

__device__ __forceinline__ unsigned xb_ld(unsigned* p)              { return __hip_atomic_load(p, __ATOMIC_RELAXED, __HIP_MEMORY_SCOPE_AGENT); }
__device__ __forceinline__ unsigned xb_add(unsigned* p, unsigned v) { return __hip_atomic_fetch_add(p, v, __ATOMIC_RELAXED, __HIP_MEMORY_SCOPE_AGENT); }
__device__ __forceinline__ unsigned xb_xcc_id() { return (unsigned)__builtin_amdgcn_s_getreg((3 << 11) | 20) & 0xFu; }
#define XB_SPIN(cond, bar) do { unsigned _sp = 0; while (cond) { __builtin_amdgcn_s_sleep(1); \
    if ((++_sp & 255u) == 0u) { if (xb_ld(&(bar)[XB_TMO])) break; if (_sp > XB_SPIN_CAP) { atomicAdd(&(bar)[XB_TMO], 1u); break; } } } } while (0)

struct XcdBarrier {
    unsigned* bar; unsigned x;
    volatile LAS unsigned* st;
};

__device__ __forceinline__ XcdBarrier xcd_barrier_post(unsigned* bar, volatile LAS unsigned* st) {
    XcdBarrier b; b.bar = bar; b.x = xb_xcc_id(); b.st = st;
    if (threadIdx.x == 0) (void)xb_add(&bar[XB_XCNT(b.x)], 1u);
    return b;
}
__device__ __forceinline__ void xcd_barrier_complete(unsigned* bar, unsigned x, unsigned& nloc, unsigned& nx) {
    const unsigned G = gridDim.x * gridDim.y * gridDim.z;
    unsigned sum, cnt, mine, sp = 0u;
    for (;;) {
        sum = 0u; cnt = 0u; mine = 0u;
#pragma unroll
        for (unsigned j = 0; j < 16; ++j) { const unsigned c = xb_ld(&bar[XB_XCNT(j)]); sum += c; cnt += (c > 0u) ? 1u : 0u; mine = (j == x) ? c : mine; }
        if (sum == G) break;
        __builtin_amdgcn_s_sleep(1);
        if ((++sp & 255u) == 0u) { if (xb_ld(&bar[XB_TMO])) break; if (sp > XB_SPIN_CAP) { atomicAdd(&bar[XB_TMO], 1u); break; } }
    }
    nloc = mine > 0u ? mine : 1u; nx = cnt > 0u ? cnt : 1u;
}

__device__ __forceinline__ void xcd_barrier(const XcdBarrier& b) {
    asm volatile("s_waitcnt vmcnt(0)" ::: "memory");
    __syncthreads();
    if (threadIdx.x == 0) {
        unsigned* bar = b.bar;
        __builtin_amdgcn_s_waitcnt(0);
        unsigned nloc = b.st[0], nx = b.st[1];
        if (nloc == 0u) { xcd_barrier_complete(bar, b.x, nloc, nx); b.st[0] = nloc; b.st[1] = nx; }
        const unsigned old = xb_add(&bar[XB_XSUB(b.x)], 1u);
        const unsigned gen = old / nloc;
        if (old + 1u == (gen + 1u) * nloc) {
            __builtin_amdgcn_fence(__ATOMIC_RELEASE, "agent");
            asm volatile("s_waitcnt vmcnt(0)" ::: "memory");
            const unsigned og = xb_add(&bar[XB_TOP], 1u);
            const unsigned tg = og / nx;
            if (og + 1u == (tg + 1u) * nx) xb_add(&bar[XB_TOPGEN], 1u);
            else XB_SPIN(xb_ld(&bar[XB_TOPGEN]) == tg, bar);
            __builtin_amdgcn_fence(__ATOMIC_ACQUIRE, "agent");
            xb_add(&bar[XB_XGEN(b.x)], 1u);
            asm volatile("s_waitcnt vmcnt(0)" ::: "memory");
        } else {
            XB_SPIN(xb_ld(&bar[XB_XGEN(b.x)]) == gen, bar);
            __builtin_amdgcn_fence(__ATOMIC_ACQUIRE, "agent");
            asm volatile("s_waitcnt vmcnt(0)" ::: "memory");
        }
    }
    __syncthreads();
}

struct Args { const float* in[12]; float* out; unsigned char* ws; };
__global__ void __launch_bounds__(NWAVES * 64, 2) trunk_fwd(Args args) {
    extern __shared__ __attribute__((aligned(16))) unsigned char lds[];
    cg::grid_group grid = cg::this_grid();
    const int tid = threadIdx.x, lane = tid & 63, wave = __builtin_amdgcn_readfirstlane(tid >> 6);
    const int G = gridDim.x, bx = blockIdx.x;
    const int vcu = (G % 8 == 0) ? (bx % 8) * (G / 8) + bx / 8 : bx;
    const int gw = vcu * NWAVES + wave, NGW = G * NWAVES;
    unsigned char* ws = args.ws;
    const float* x_in = args.in[0]; const float* norm_g = args.in[1]; const float* w_in = args.in[2]; const float* w_out = args.in[3]; const float* conv_w = args.in[4];
    const float* lq1 = args.in[5]; const float* lk1 = args.in[6]; const float* lq2 = args.in[7]; const float* lk2 = args.in[8];
    const float* subln_g = args.in[9]; const float* rel_bias = args.in[10]; const float* final_g = args.in[11];
    float* X = args.out;
    bf16* Win_t = (bf16*)(ws + WS_WIN); bf16* Wout_t = (bf16*)(ws + WS_WOUT); bf16* XN = (bf16*)(ws + WS_XN); bf16* Y = (bf16*)(ws + WS_Y); bf16* P = (bf16*)(ws + WS_P);
    LAS unsigned char* ldsl = (LAS unsigned char*)lds;
    volatile LAS unsigned* MISC = (volatile LAS unsigned*)(ldsl + RING_BYTES + 320);
    if (tid < 32) MISC[tid] = 0u;
    __syncthreads();
    const XcdBarrier bar = xcd_barrier_post((unsigned*)ws, MISC + 8);
#define GRID_BAR() xcd_barrier(bar)

    {
        LAS float* scr = (LAS float*)(ldsl + wave * 16384);
        constexpr int I_IN = (D / 64) * (NP / 64), I_OUT = (D / 64) * (D / 64);
        constexpr int NITEMS = DEPTH * (I_IN + I_OUT);
        for (int it = gw; it < NITEMS; it += NGW) {
            if (it < DEPTH * I_IN) { const int l = it / I_IN, r = it % I_IN; p0_transpose_item(w_in + (size_t)l * D * NP, D, NP, Win_t + (size_t)l * NP * D, (l & 1) == 0, scr, r, lane, nullptr); }
            else { const int it2 = it - DEPTH * I_IN; const int l = it2 / I_OUT, r = it2 % I_OUT; p0_transpose_item(w_out + (size_t)l * D * D, D, D, Wout_t + (size_t)l * D * D, 0, scr, r, lane, nullptr); }
        }
        rms_rows_bf16(x_in, norm_g, XN, gw, NGW, lane);
    }
    grid.sync();

    for (int l = 0; l < DEPTH; ++l) {
        const bool is_attn = (l & 1) != 0; const int j = l >> 1;
        if (l > 0) { rms_rows_bf16(X, norm_g + (size_t)l * D, XN, gw, NGW, lane); GRID_BAR(); }
        {
            pg8::Gemm g{XN, Win_t + (size_t)l * NP * D, M, NP, D}; pg8::StaticOrder S; S.init(M, NP, G, bx);
            if (is_attn) { pg8::EpiAttn E{P, (unsigned char*)P + 128 * MiB, attn_body::C2}; pg8::gemm_phase<pg8::EpiAttn, pg8::StaticOrder, true, true>(ldsl, g, S, E); }
            else { pg8::EpiConvGate E{P, P + (size_t)M * D}; pg8::gemm_phase<pg8::EpiConvGate, pg8::StaticOrder, true, true>(ldsl, g, S, E); }
        }
        GRID_BAR();
        if (is_attn) {
            const float linit = 0.8f - 0.6f * expf(-0.3f * (float)l);
            const float d1 = wave_sum(lq1[j * 64 + lane] * lk1[j * 64 + lane]), d2 = wave_sum(lq2[j * 64 + lane] * lk2[j * 64 + lane]);
            const float lam = expf(d1) - expf(d2) + linit;
            for (int rep = 0; rep < PROBE_ATTN_REP; ++rep) {
            attn_body::AttnArgs A{P, (const unsigned char*)P + 128 * MiB, rep == 0 ? Y : XN, rel_bias, subln_g + (size_t)j * 128, lam, 1.0f - linit};
            for (int v = vcu; v < 256; v += G) {
                const int s = v & 7, bh = v >> 3;
#pragma unroll 1
                for (int i = 0; i < 8; ++i) { const int qb = (i & 1) ? (16 * (i >> 1) + 15 - s) : (16 * (i >> 1) + s);
                    attn_body::attn_unit<8>(bh / attn_body::NHEAD, bh % attn_body::NHEAD, qb, A, (char*)lds, i == 0); }
            }
            }
        } else {
            conv_pass(P, P + (size_t)M * D, conv_w + (size_t)j * D * 3, Y, vcu * (NWAVES * 64) + fresh_tid(), G * NWAVES * 64);
        }
        GRID_BAR();
        {
            pg8::Gemm g{Y, Wout_t + (size_t)l * D * D, M, D, D}; pg8::StaticOrder S; S.init(M, D, G, bx);
            pg8::EpiRes E{l == 0 ? x_in : X, X, D};
            pg8::gemm_phase<pg8::EpiRes, pg8::StaticOrder, true, true>(ldsl, g, S, E);
        }
        GRID_BAR();
    }
    rms_rows_f32_inplace(X, final_g, gw, NGW, lane);
}

extern "C" void kernel_launch(void* const* d_in, const int* in_sizes, int n_in, void* d_out, int out_size, void* d_ws, size_t ws_size, hipStream_t stream) {
    static int grid = 0;
    if (grid == 0) {
        if (n_in != 12 || in_sizes[0] != M * D || out_size != M * D || ws_size < WS_END) { fprintf(stderr, "kernel_launch: unexpected shapes: n_in %d in0 %d out %d ws %zu (need %zu)\n", n_in, n_in > 0 ? in_sizes[0] : -1, out_size, ws_size, (size_t)WS_END); grid = -1; return; }
        int dev = 0, cus = 0, per_cu = 0;
        hipGetDevice(&dev); hipDeviceGetAttribute(&cus, hipDeviceAttributeMultiprocessorCount, dev);
        if (hipFuncSetAttribute((const void*)trunk_fwd, hipFuncAttributeMaxDynamicSharedMemorySize, LDS_BYTES) != hipSuccess) { fprintf(stderr, "kernel_launch: hipFuncSetAttribute failed\n"); grid = -1; return; }
        if (hipOccupancyMaxActiveBlocksPerMultiprocessor(&per_cu, (const void*)trunk_fwd, NWAVES * 64, LDS_BYTES) != hipSuccess || per_cu < 1) { fprintf(stderr, "kernel_launch: occupancy query gave %d\n", per_cu); per_cu = 1; }
        (void)hipGetLastError();
        grid = cus;
        fprintf(stderr, "kernel_launch: grid %d (cus %d, per_cu %d)\n", grid, cus, per_cu);
    }
    if (grid < 0) return;
    if (hipMemsetAsync(d_ws, 0, 65536, stream) != hipSuccess) { fprintf(stderr, "kernel_launch: memset failed\n"); return; }
    Args a{};
    for (int i = 0; i < 12; ++i) a.in[i] = (const float*)d_in[i];
    a.out = (float*)d_out; a.ws = (unsigned char*)d_ws;
    void* kargs[] = {&a};
    hipError_t e = hipLaunchCooperativeKernel((const void*)trunk_fwd, dim3(grid), dim3(NWAVES * 64), kargs, LDS_BYTES, stream);
    if (e != hipSuccess) fprintf(stderr, "kernel_launch: cooperative launch failed: %s (grid %d)\n", hipGetErrorString(e), grid);
}
```
